# Optimizing an MI355X kernel written in HIP

```python
import math
import jax, jax.numpy as jnp
from jax import lax
import numpy as np

D_MODEL = 1024
BATCH = 8
SEQ = 2048
DEPTH = 4

N_MIXERS = 3
N_LAYERS_A = len(range(0, DEPTH, N_MIXERS))
N_LAYERS_B = len(range(1, DEPTH, N_MIXERS))
N_LAYERS_C = len(range(2, DEPTH, N_MIXERS))

DEEPNORM_ALPHA = (2.0 * DEPTH) ** 0.25
DEEPNORM_BETA = (8.0 * DEPTH) ** -0.25
LN_EPS = 1e-5

A_HEADS = 8
A_HEAD_DIM = D_MODEL // A_HEADS
MOBA_BLOCK = 256
MOBA_TOPK = 3
MOBA_Q_CHUNK = 16
REL_BUCKETS = 32
REL_MAX_DIST = 128

B_GROUPS = 8
B_WIDTH = 2 * D_MODEL
B_CHUNK = 128

C_HEADS = 4
C_KEY_DIM = D_MODEL // 2
C_VAL_DIM = D_MODEL
C_DK = C_KEY_DIM // C_HEADS
C_DV = C_VAL_DIM // C_HEADS
C_GATE_RANK = 16
C_GATE_NORMALIZER = 16.0
C_CHUNK = 64
C_IN_WIDTH = 2 * C_KEY_DIM + 2 * C_VAL_DIM + C_GATE_RANK

N_EXPERTS = 32
TOP_K = 4
D_EXPERT = D_MODEL
SWIGLU_LIMIT = 7.0
SWIGLU_ALPHA = 1.702
MOE_ROW_BLOCK = 128

kernel_name = "hybrid_moba_gmlp_gla_moe_deepnorm"


def layer_norm(x, g, b):
    xf = x.astype(jnp.float32)
    mu = xf.mean(-1, keepdims=True)
    var = jnp.square(xf - mu).mean(-1, keepdims=True)
    y = (xf - mu) * lax.rsqrt(var + LN_EPS) * g.astype(jnp.float32) + b.astype(jnp.float32)
    return y.astype(x.dtype)


def rms_norm(x, g):
    xf = x.astype(jnp.float32)
    return xf * lax.rsqrt(jnp.mean(xf * xf, -1, keepdims=True) + LN_EPS) * g.astype(jnp.float32)


def t5_bucket(rel):
    n = jnp.maximum(rel, 0)
    max_exact = REL_BUCKETS // 2
    nf = jnp.maximum(n, 1).astype(jnp.float32)
    large = max_exact + (jnp.log(nf / max_exact) / math.log(REL_MAX_DIST / max_exact)
                         * (REL_BUCKETS - max_exact)).astype(jnp.int32)
    large = jnp.minimum(large, REL_BUCKETS - 1)
    return jnp.where(n < max_exact, n, large)


def moba_attention(x, w_in, w_out, rel_bias):
    B, S, _ = x.shape
    H, Dh, BLK, QC = A_HEADS, A_HEAD_DIM, MOBA_BLOCK, MOBA_Q_CHUNK
    qkv = (x @ w_in).reshape(B, S, 3, H, Dh)
    q = qkv[:, :, 0].transpose(0, 2, 1, 3)
    k = qkv[:, :, 1].transpose(0, 2, 1, 3)
    v = qkv[:, :, 2].transpose(0, 2, 1, 3)
    nb = -(-S // BLK)
    pad = nb * BLK - S
    kb = jnp.pad(k, ((0, 0), (0, 0), (0, pad), (0, 0))).reshape(B, H, nb, BLK, Dh)
    vb = jnp.pad(v, ((0, 0), (0, 0), (0, pad), (0, 0))).reshape(B, H, nb, BLK, Dh)
    k_mean = kb.astype(jnp.float32).mean(axis=3)
    gate = jnp.einsum('bhsd,bhnd->bhsn', q.astype(jnp.float32), k_mean)
    pos = jnp.arange(S)
    past = jnp.arange(nb)[None, :] < (pos // BLK)[:, None]
    gate = jnp.where(past, gate, -jnp.inf)
    k_sel = min(MOBA_TOPK, nb)
    sel_score, sel_idx = lax.top_k(gate, k_sel)
    sel_valid = jnp.isfinite(sel_score)

    rel_t = rel_bias.T
    bi = jnp.arange(B)[:, None, None, None]
    hi = jnp.arange(H)[None, :, None, None]
    scale = Dh ** -0.5
    offs = jnp.arange(BLK)

    def attend_chunk(t0):
        qc = lax.dynamic_slice_in_dim(q, t0, QC, axis=2)
        idx = lax.dynamic_slice_in_dim(sel_idx, t0, QC, axis=2)
        valid = lax.dynamic_slice_in_dim(sel_valid, t0, QC, axis=2)
        qpos = t0 + jnp.arange(QC)
        kg = kb[bi, hi, idx]
        vg = vb[bi, hi, idx]
        s_sel = jnp.einsum('bhqd,bhqnjd->bhqnj', qc, kg).astype(jnp.float32) * scale
        rel_sel = qpos[None, None, :, None, None] - (idx[..., None] * BLK + offs)
        s_sel = jnp.where(valid[..., None],
                          s_sel + rel_t[hi[..., None], t5_bucket(rel_sel)], -jnp.inf)
        own = t0 // BLK
        ko = lax.dynamic_index_in_dim(kb, own, axis=2, keepdims=False)
        vo = lax.dynamic_index_in_dim(vb, own, axis=2, keepdims=False)
        rel_own = qpos[:, None] - (own * BLK + offs)[None, :]
        s_own = (jnp.einsum('bhqd,bhjd->bhqj', qc, ko).astype(jnp.float32) * scale
                 + rel_t[:, t5_bucket(rel_own)])
        s_own = jnp.where(rel_own >= 0, s_own, -jnp.inf)
        logits = jnp.concatenate([s_sel.reshape(B, H, QC, k_sel * BLK), s_own], axis=-1)
        p = jax.nn.softmax(logits, axis=-1).astype(v.dtype)
        p_sel = p[..., :k_sel * BLK].reshape(B, H, QC, k_sel, BLK)
        p_own = p[..., k_sel * BLK:]
        return (jnp.einsum('bhqnj,bhqnjd->bhqd', p_sel, vg)
                + jnp.einsum('bhqj,bhjd->bhqd', p_own, vo))

    o = lax.map(attend_chunk, jnp.arange(0, S, QC))
    o = o.transpose(1, 0, 3, 2, 4).reshape(B, S, H * Dh)
    return o @ w_out


def gmlp_mixer(x, w_in, ln_g, ln_b, w_s, b_s, w_out):
    B, S, _ = x.shape
    z = jax.nn.gelu(x @ w_in, approximate=False)
    u, v = jnp.split(z, 2, axis=-1)
    v = layer_norm(v, ln_g, ln_b)
    gw = B_WIDTH // B_GROUPS
    vc = v.reshape(B, S // B_CHUNK, B_CHUNK, B_GROUPS, gw)
    ws = w_s * jnp.tril(jnp.ones((B_CHUNK, B_CHUNK), w_s.dtype))
    mixed = jnp.einsum('gts,bcsge->bctge', ws, vc) + b_s.T[None, None, :, :, None]
    y = u * mixed.reshape(B, S, B_WIDTH)
    return y @ w_out


def gla_mixer(x, w_in, w_gk_up, b_gk, norm_g, w_out):
    B, S, _ = x.shape
    proj = x @ w_in
    splits = [C_KEY_DIM, 2 * C_KEY_DIM, 2 * C_KEY_DIM + C_VAL_DIM, 2 * C_KEY_DIM + 2 * C_VAL_DIM]
    q, k, v, g, gk_low = jnp.split(proj, splits, axis=-1)
    log_a = jax.nn.log_sigmoid((gk_low @ w_gk_up + b_gk).astype(jnp.float32)) / C_GATE_NORMALIZER
    nc = S // C_CHUNK

    def heads(t, dh):
        return t.astype(jnp.float32).reshape(B, nc, C_CHUNK, C_HEADS, dh).transpose(1, 0, 3, 2, 4)

    qh = heads(q, C_DK) * (C_DK ** -0.5)
    kh = heads(k, C_DK)
    vh = heads(v, C_DV)
    ah = heads(log_a, C_DK)
    causal = jnp.tril(jnp.ones((C_CHUNK, C_CHUNK), bool))

    def step(state, inp):
        qc, kc, vc, ac = inp
        b = jnp.cumsum(ac, axis=2)
        o_inter = jnp.einsum('bhck,bhkv->bhcv', qc * jnp.exp(b), state)
        diff = b[:, :, :, None, :] - b[:, :, None, :, :]
        diff = jnp.where(causal[None, None, :, :, None], diff, -jnp.inf)
        att = jnp.einsum('bhik,bhjk,bhijk->bhij', qc, kc, jnp.exp(diff))
        o_intra = jnp.einsum('bhij,bhjv->bhiv', att, vc)
        b_last = b[:, :, -1:, :]
        new_state = (jnp.exp(b_last[:, :, 0, :])[..., None] * state
                     + jnp.einsum('bhck,bhcv->bhkv', kc * jnp.exp(b_last - b), vc))
        return new_state, o_inter + o_intra

    state0 = jnp.zeros((B, C_HEADS, C_DK, C_DV), jnp.float32)
    _, o = lax.scan(step, state0, (qh, kh, vh, ah))
    o = o.transpose(1, 0, 3, 2, 4).reshape(B, S, C_HEADS, C_DV)
    o = rms_norm(o, norm_g) * jax.nn.silu(g.reshape(B, S, C_HEADS, C_DV).astype(jnp.float32))
    return o.reshape(B, S, C_VAL_DIM).astype(x.dtype) @ w_out


def moe_ffn(x, w_router, b_router, w_gu, b_gu, w_down, b_down):
    B, S, D = x.shape
    T = B * S
    xt = x.reshape(T, D)
    logits = (xt @ w_router + b_router).astype(jnp.float32)
    top_logit, top_e = lax.top_k(logits, TOP_K)
    gate = jax.nn.softmax(top_logit, axis=-1)
    n_assign = T * TOP_K
    flat_e = top_e.reshape(-1)
    flat_tok = jnp.arange(n_assign) // TOP_K
    order = jnp.argsort(flat_e)
    e_sorted = flat_e[order]
    tok_sorted = flat_tok[order]
    gate_sorted = gate.reshape(-1)[order]
    counts = jnp.zeros((N_EXPERTS,), jnp.int32).at[flat_e].add(1)
    padded = (counts + MOE_ROW_BLOCK - 1) // MOE_ROW_BLOCK * MOE_ROW_BLOCK
    start = jnp.cumsum(counts) - counts
    pend = jnp.cumsum(padded)
    pstart = pend - padded
    dest = pstart[e_sorted] + (jnp.arange(n_assign) - start[e_sorted])
    n_blocks = -(-n_assign // MOE_ROW_BLOCK) + N_EXPERTS
    n_rows = n_blocks * MOE_ROW_BLOCK
    row_tok = jnp.full((n_rows,), T, jnp.int32).at[dest].set(tok_sorted)
    x_pad = jnp.concatenate([xt, jnp.zeros((1, D), xt.dtype)], axis=0)
    xs = x_pad[row_tok].reshape(n_blocks, MOE_ROW_BLOCK, D)
    block_e = jnp.minimum(
        jnp.searchsorted(pend, jnp.arange(n_blocks) * MOE_ROW_BLOCK, side='right'), N_EXPERTS - 1)

    def expert_block(args):
        xb, e = args
        h = xb @ w_gu[e] + b_gu[e]
        h_gate, h_up = jnp.split(h, 2, axis=-1)
        h_gate = jnp.minimum(h_gate, SWIGLU_LIMIT)
        h_up = jnp.clip(h_up, -SWIGLU_LIMIT, SWIGLU_LIMIT)
        act = h_gate * jax.nn.sigmoid(SWIGLU_ALPHA * h_gate) * (h_up + 1.0)
        return act @ w_down[e] + b_down[e]

    ys = lax.map(expert_block, (xs, block_e)).reshape(n_rows, D)
    y_assign = ys[dest] * gate_sorted[:, None].astype(ys.dtype)
    y = jax.ops.segment_sum(y_assign, tok_sorted, num_segments=T)
    return y.reshape(B, S, D)


def setup_inputs(seed: int = 0) -> dict:
    key = jax.random.key(seed)
    ks = jax.random.split(key, 23)
    f32 = jnp.float32
    D = D_MODEL

    def nrm(k, shape, scale):
        return jax.random.normal(k, shape, f32) * scale

    return {
        "x": nrm(ks[0], (BATCH, SEQ, D), 1.0),
        "rel_bias": nrm(ks[1], (REL_BUCKETS, A_HEADS), 0.5),
        "a_w_in": nrm(ks[2], (N_LAYERS_A, D, 3 * D), D ** -0.5),
        "a_w_out": nrm(ks[3], (N_LAYERS_A, D, D), D ** -0.5 * DEEPNORM_BETA),
        "b_w_in": nrm(ks[4], (N_LAYERS_B, D, 2 * B_WIDTH), D ** -0.5),
        "b_ln_g": 1.0 + nrm(ks[5], (N_LAYERS_B, B_WIDTH), 0.02),
        "b_ln_b": nrm(ks[6], (N_LAYERS_B, B_WIDTH), 0.02),
        "b_w_s": nrm(ks[7], (N_LAYERS_B, B_GROUPS, B_CHUNK, B_CHUNK), B_CHUNK ** -0.5),
        "b_b_s": 1.0 + nrm(ks[8], (N_LAYERS_B, B_GROUPS, B_CHUNK), 0.02),
        "b_w_out": nrm(ks[9], (N_LAYERS_B, B_WIDTH, D), B_WIDTH ** -0.5 * DEEPNORM_BETA),
        "c_w_in": nrm(ks[10], (N_LAYERS_C, D, C_IN_WIDTH), D ** -0.5),
        "c_w_gk_up": nrm(ks[11], (N_LAYERS_C, C_GATE_RANK, C_KEY_DIM), C_GATE_RANK ** -0.5),
        "c_b_gk": nrm(ks[12], (N_LAYERS_C, C_KEY_DIM), 0.1),
        "c_norm_g": 1.0 + nrm(ks[13], (N_LAYERS_C, C_DV), 0.02),
        "c_w_out": nrm(ks[14], (N_LAYERS_C, C_VAL_DIM, D), C_VAL_DIM ** -0.5 * DEEPNORM_BETA),
        "ln_g": 1.0 + nrm(ks[15], (DEPTH, 2, D), 0.02),
        "ln_b": nrm(ks[16], (DEPTH, 2, D), 0.02),
        "moe_w_router": nrm(ks[17], (DEPTH, D, N_EXPERTS), D ** -0.5),
        "moe_b_router": nrm(ks[18], (DEPTH, N_EXPERTS), 0.01),
        "moe_w_gate_up": nrm(ks[19], (DEPTH, N_EXPERTS, D, 2 * D_EXPERT), D ** -0.5),
        "moe_b_gate_up": nrm(ks[20], (DEPTH, N_EXPERTS, 2 * D_EXPERT), 0.01),
        "moe_w_down": nrm(ks[21], (DEPTH, N_EXPERTS, D_EXPERT, D), D_EXPERT ** -0.5 * DEEPNORM_BETA),
        "moe_b_down": nrm(ks[22], (DEPTH, N_EXPERTS, D), 0.01),
    }


def reference(x, rel_bias, a_w_in, a_w_out, b_w_in, b_ln_g, b_ln_b, b_w_s, b_b_s, b_w_out,
              c_w_in, c_w_gk_up, c_b_gk, c_norm_g, c_w_out, ln_g, ln_b,
              moe_w_router, moe_b_router, moe_w_gate_up, moe_b_gate_up, moe_w_down, moe_b_down):
    h = x
    for i in range(DEPTH):
        j = i // N_MIXERS
        mixer = i % N_MIXERS
        if mixer == 0:
            t = moba_attention(h, a_w_in[j], a_w_out[j], rel_bias)
        elif mixer == 1:
            t = gmlp_mixer(h, b_w_in[j], b_ln_g[j], b_ln_b[j], b_w_s[j], b_b_s[j], b_w_out[j])
        else:
            t = gla_mixer(h, c_w_in[j], c_w_gk_up[j], c_b_gk[j], c_norm_g[j], c_w_out[j])
        h = layer_norm(DEEPNORM_ALPHA * h + t, ln_g[i, 0], ln_b[i, 0])
        f = moe_ffn(h, moe_w_router[i], moe_b_router[i], moe_w_gate_up[i], moe_b_gate_up[i],
                    moe_w_down[i], moe_b_down[i])
        h = layer_norm(DEEPNORM_ALPHA * h + f, ln_g[i, 1], ln_b[i, 1])
    return h
```

```cpp
#include <hip/hip_runtime.h>
#include <cstdio>
#include <cstdint>

#ifndef PROBE_MASK
#define PROBE_MASK 0ull
#endif
#ifndef ATT_REP
#define ATT_REP 1
#endif
#ifndef MK_ONE_LAUNCH
#define MK_ONE_LAUNCH 1
#endif

#define GAS __attribute__((address_space(1)))
#define LAS __attribute__((address_space(3)))
typedef unsigned short bf16;
typedef short bf16x8 __attribute__((ext_vector_type(8)));
typedef float f32x4 __attribute__((ext_vector_type(4)));
typedef float f32x2 __attribute__((ext_vector_type(2)));
typedef unsigned u32x4 __attribute__((ext_vector_type(4)));
typedef unsigned u32x2 __attribute__((ext_vector_type(2)));
typedef GAS unsigned gu32;
typedef int i32x4 __attribute__((ext_vector_type(4)));
typedef int i32x8 __attribute__((ext_vector_type(8)));
#define FP8_GU_SHIFT 6
#define FP8_GU_SCALE 0x79797979
#define FP8_DN_SHIFT 7
#define FP8_DN_SCALE 0x7b7b7b7b

constexpr int BATCH = 8, SEQ = 2048, T = BATCH * SEQ, D = 1024, NLAYER = 4, NE = 32, TOPK = 4;
constexpr int AH = 8, ADH = 128, MBLK = 256;
constexpr int BW = 2048, BG = 8, BCH = 128;
constexpr int CH = 4, CDK = 128, CDV = 256, CKEY = 512, CVAL = 1024, CRANK = 16, CIN = 3088;
constexpr float ALPHA = 1.6817928305074292f;
constexpr float LN_EPS = 1e-5f;
constexpr int NWAVES = 8, NTHR = 512;

constexpr size_t MiB = 1u << 20;
constexpr size_t WS_CTL = 0, CTL_ZERO_BYTES = 64 * 1024;
constexpr size_t WS_WRT = 1 * MiB;
constexpr size_t WS_AIN = 2 * MiB;
constexpr size_t WS_AOUT = 14 * MiB;
constexpr size_t WS_BIN = 18 * MiB;
constexpr size_t WS_BOUT = 26 * MiB;
constexpr size_t WS_CIN = 30 * MiB;
constexpr size_t WS_COUT = 36 * MiB;
constexpr size_t WS_GU = 64 * MiB;
constexpr size_t WS_DN = 576 * MiB;
constexpr size_t WS_HB = 832 * MiB;
constexpr size_t WS_U = 864 * MiB;
constexpr size_t WS_BIG1 = 928 * MiB;
constexpr size_t WS_BIG2 = 1056 * MiB;
constexpr size_t WS_BIG3 = 1120 * MiB;
constexpr size_t WS_ACT = 1248 * MiB;
constexpr size_t WS_YS = 1392 * MiB;
constexpr size_t WS_TOK = 1536 * MiB;
constexpr size_t WS_SELE = 1538 * MiB;
constexpr size_t WS_SELP = WS_SELE + 256 * 1024;
constexpr size_t WS_SELG = WS_SELP + 256 * 1024;
constexpr size_t WS_KMEAN = 1540 * MiB;
constexpr size_t WS_STATS = 1541 * MiB;
constexpr size_t WS_GKL = 1545 * MiB;
constexpr size_t WS_W16T = WS_WRT + 512 * 1024;
constexpr size_t WS_END = 1600 * MiB;
constexpr int CW_BAR = 4096;
constexpr int CW_CV = 12288;
constexpr int CW_CNT = 8192;

constexpr int RING_BYTES = 131072;
constexpr int MISC_OFF = RING_BYTES;
constexpr int IDX_OFF = RING_BYTES + 4096;
constexpr int LDS_BYTES = 147456;
constexpr int MAXU = 12;

__device__ __forceinline__ float bf2f(bf16 b) { return __uint_as_float(((unsigned)b) << 16); }
__device__ __forceinline__ unsigned cvt_pk_bf16(float lo, float hi) { unsigned r; asm volatile("v_cvt_pk_bf16_f32 %0, %1, %2" : "=v"(r) : "v"(lo), "v"(hi)); return r; }
__device__ __forceinline__ bf16 f2bf(float f) { return (bf16)(cvt_pk_bf16(f, 0.f) & 0xffffu); }
__device__ __forceinline__ float wave_sum(float v) {
#pragma unroll
    for (int o = 1; o < 64; o <<= 1) v += __shfl_xor(v, o);
    return v;
}
__device__ __forceinline__ float wave_max(float v) {
#pragma unroll
    for (int o = 1; o < 64; o <<= 1) v = fmaxf(v, __shfl_xor(v, o));
    return v;
}
__device__ __forceinline__ int opaque_tid() { int t = threadIdx.x; asm volatile("" : "+v"(t)); return t; }
#define LDS_WAIT() asm volatile("s_waitcnt lgkmcnt(0)" ::: "memory")
#define VM_WAIT() asm volatile("s_waitcnt vmcnt(0)" ::: "memory")

namespace pg8 {
constexpr int BM = 256, BK = 64, HALF = 128, HTB = HALF * BK * 2, STAGE_BYTES = 8 * HTB, NXCD = 8, WGM = 8;
__host__ __device__ __forceinline__ int lds_byte(int r, int c) { const int st = (r >> 4) * 2 + (c >> 5), rr = r & 15, cc = c & 31, ob = rr * 64 + cc * 2; return st * 1024 + (ob ^ (((ob >> 9) & 1) << 5)); }
__host__ __device__ __forceinline__ void stage_rc(int b, int& R, int& C) { const int st = b / 1024, sb = b % 1024, swz = sb ^ (((sb >> 9) & 1) << 5); R = (st >> 1) * 16 + swz / 64; C = (st & 1) * 32 + (swz % 64) / 2; }
__host__ __device__ __forceinline__ int perm32(int rho) { const int n = rho >> 4, i = rho & 15; return 8 * (i >> 2) + 4 * n + (i & 3); }

struct Unit { int pm, pn, e, pnl; };
struct Gemm { const bf16* A; const bf16* Bt; int K; int scw = 0x7f7f7f7f; };

struct StaticOrder {
    int nM, nN, nwg, G, c;
    __device__ void init(int nM_, int nN_, int G_, int c_) { nM = nM_; nN = nN_; nwg = nM * nN; G = G_; c = c_; }
    __device__ __forceinline__ bool next(int i, Unit& u) const {
        const long L = (long)i * G + c; if (L >= nwg) return false;
        int wgid = (int)L; { const int q = nwg / NXCD, r = nwg % NXCD, xcd = wgid % NXCD, off = wgid / NXCD; wgid = (xcd < r ? xcd * (q + 1) : r * (q + 1) + (xcd - r) * q) + off; }
        const int nig = WGM * nN, gid = wgid / nig, fm = gid * WGM, gsz = (nM - fm) < WGM ? (nM - fm) : WGM;
        u.pm = fm + ((wgid % nig) % gsz); u.pn = (wgid % nig) / gsz; u.e = 0; u.pnl = u.pn; return true;
    }
    __device__ __forceinline__ int rowidx(int, int) const { return 0; }
};
struct MoeOrder {
    StaticOrder so; const LAS int* tile_e; const LAS int* idx;
    __device__ __forceinline__ bool next(int i, Unit& u) const {
        const int nN = so.nN, nM = so.nM;
        int pmv, pnv;
        if ((so.G & 7) != 0) { Unit t_; t_.pm = 0; t_.pn = 0; if (!so.next(i, t_)) return false; pmv = t_.pm; pnv = t_.pn; }
        else { const int x = so.c & 7, j = so.c >> 3, per = so.G >> 3, t0 = (x * nM) >> 3, nl = (((x + 1) * nM) >> 3) - t0, Lx = i * per + j;
            if (Lx >= nl * nN) return false;
            const int MW = 32 / nN;
            const int nig = MW * nN, gid = Lx / nig, fm = gid * MW, gsz = (nl - fm) < MW ? (nl - fm) : MW, idx = Lx % nig;
            pmv = t0 + fm + idx % gsz; pnv = idx / gsz; }
        u.pm = pmv; u.e = tile_e[pmv]; u.pnl = pnv; u.pn = u.e * nN + pnv; return true;
    }
    __device__ __forceinline__ int rowidx(int i, int r) const { return idx[i * 256 + r]; }
};

__device__ __forceinline__ f32x2 gelu_pk(f32x2 v) {
    const f32x2 av = __builtin_elementwise_abs(v), d = av * 0.2316418882f + 1.0f;
    f32x2 t; t.x = __builtin_amdgcn_rcpf(d.x); t.y = __builtin_amdgcn_rcpf(d.y);
    f32x2 q = t * 0.5307027145f + (-0.7265760135f); q = q * t + 0.7107068705f; q = q * t + (-0.142248368f); q = q * t + 0.127414796f; q = q * t;
    const f32x2 s = (v * v) * (-0.72134752044f);
    f32x2 e; e.x = __builtin_amdgcn_exp2f(s.x); e.y = __builtin_amdgcn_exp2f(s.y);
    const f32x2 m = v * (q * e), r = v - m;
    f32x2 o; o.x = v.x < 0.f ? m.x : r.x; o.y = v.y < 0.f ? m.y : r.y; return o;
}

struct EpiBf16 {
    static constexpr bool PERM = true;
    bf16* O; int ldc; float* KP = nullptr;
    __device__ __forceinline__ void operator()(const f32x4 (&acc)[2][2][4][2], const Unit& u, int wr, int wc, int fr, int fq) const {
        const int row0 = u.pm * BM + wr * 64 + fr, col0 = u.pnl * BM + wc * 32 + 8 * fq;
        if (KP != nullptr && u.pnl >= 4 && u.pnl < 8) {
#pragma unroll
            for (int bj = 0; bj < 2; ++bj)
#pragma unroll
                for (int n = 0; n < 2; ++n) { f32x4 cs = acc[0][bj][0][n];
#pragma unroll
                    for (int m = 1; m < 4; ++m) cs += acc[0][bj][m][n];
#pragma unroll
                    for (int m = 0; m < 4; ++m) cs += acc[1][bj][m][n];
#pragma unroll
                    for (int e = 0; e < 4; ++e) { float v = cs[e]; v += __shfl_xor(v, 1); v += __shfl_xor(v, 2); v += __shfl_xor(v, 4); v += __shfl_xor(v, 8); cs[e] = v; }
                    if (fr == 0) *(f32x4*)(KP + ((size_t)u.pm * 2 + wr) * 1024 + (u.pnl - 4) * BM + wc * 32 + 8 * fq + bj * HALF + 4 * n) = cs; }
        }
#pragma unroll
        for (int ai = 0; ai < 2; ++ai)
#pragma unroll
            for (int m = 0; m < 4; ++m) { bf16* rowp = O + (size_t)(row0 + ai * HALF + m * 16) * ldc + col0;
#pragma unroll
                for (int bj = 0; bj < 2; ++bj) { const f32x4 v0 = acc[ai][bj][m][0], v1 = acc[ai][bj][m][1];
                    u32x4 w; w.x = cvt_pk_bf16(v0[0], v0[1]); w.y = cvt_pk_bf16(v0[2], v0[3]); w.z = cvt_pk_bf16(v1[0], v1[1]); w.w = cvt_pk_bf16(v1[2], v1[3]);
                    *(u32x4*)(rowp + bj * HALF) = w; } }
    }
};
struct EpiYs8 {
    static constexpr bool PERM = true;
    unsigned char* O;
    __device__ __forceinline__ void operator()(const f32x4 (&acc)[2][2][4][2], const Unit& u, int wr, int wc, int fr, int fq) const {
        const int row0 = u.pm * BM + wr * 64 + fr, col0 = u.pnl * BM + wc * 32 + 8 * fq;
#pragma unroll
        for (int ai = 0; ai < 2; ++ai)
#pragma unroll
            for (int m = 0; m < 4; ++m) { unsigned char* rowp = O + (size_t)(row0 + ai * HALF + m * 16) * 1024 + col0;
#pragma unroll
                for (int bj = 0; bj < 2; ++bj) { const f32x4 v0 = acc[ai][bj][m][0], v1 = acc[ai][bj][m][1];
                    int w0 = 0, w1 = 0; w0 = __builtin_amdgcn_cvt_pk_fp8_f32(v0[0], v0[1], w0, false); w0 = __builtin_amdgcn_cvt_pk_fp8_f32(v0[2], v0[3], w0, true);
                    w1 = __builtin_amdgcn_cvt_pk_fp8_f32(v1[0], v1[1], w1, false); w1 = __builtin_amdgcn_cvt_pk_fp8_f32(v1[2], v1[3], w1, true);
                    u32x2 w; w.x = (unsigned)w0; w.y = (unsigned)w1; *(u32x2*)(rowp + bj * HALF) = w; } }
    }
};
struct EpiResid {
    static constexpr bool PERM = true;
    const bf16* H; bf16* U; float alpha;
    __device__ __forceinline__ void operator()(const f32x4 (&acc)[2][2][4][2], const Unit& u, int wr, int wc, int fr, int fq) const {
        const int row0 = u.pm * BM + wr * 64 + fr, col0 = u.pnl * BM + wc * 32 + 8 * fq;
#pragma unroll
        for (int ai = 0; ai < 2; ++ai)
#pragma unroll
            for (int m = 0; m < 4; ++m) { const size_t off = (size_t)(row0 + ai * HALF + m * 16) * D + col0;
#pragma unroll
                for (int bj = 0; bj < 2; ++bj) { const u32x4 hv = *(const u32x4*)(H + off + bj * HALF); const f32x4 v0 = acc[ai][bj][m][0], v1 = acc[ai][bj][m][1];
                    const f32x2 r0 = (f32x2){__uint_as_float(hv.x << 16), __uint_as_float(hv.x & 0xffff0000u)} * alpha + (f32x2){v0[0], v0[1]}, r1 = (f32x2){__uint_as_float(hv.y << 16), __uint_as_float(hv.y & 0xffff0000u)} * alpha + (f32x2){v0[2], v0[3]};
                    const f32x2 r2 = (f32x2){__uint_as_float(hv.z << 16), __uint_as_float(hv.z & 0xffff0000u)} * alpha + (f32x2){v1[0], v1[1]}, r3 = (f32x2){__uint_as_float(hv.w << 16), __uint_as_float(hv.w & 0xffff0000u)} * alpha + (f32x2){v1[2], v1[3]};
                    u32x4 w; w.x = cvt_pk_bf16(r0.x, r0.y); w.y = cvt_pk_bf16(r1.x, r1.y); w.z = cvt_pk_bf16(r2.x, r2.y); w.w = cvt_pk_bf16(r3.x, r3.y);
                    *(u32x4*)(U + off + bj * HALF) = w; } }
    }
};
struct EpiGelu {
    static constexpr bool PERM = true;
    bf16* Z; float* ST;
    __device__ __forceinline__ void operator()(const f32x4 (&acc)[2][2][4][2], const Unit& u, int wr, int wc, int fr, int fq) const {
        const int row0 = u.pm * BM + wr * 64 + fr, col0 = u.pnl * BM + wc * 32 + 8 * fq;
#pragma unroll
        for (int ai = 0; ai < 2; ++ai)
#pragma unroll
            for (int m = 0; m < 4; ++m) { const int row = row0 + ai * HALF + m * 16; bf16* rowp = Z + (size_t)row * 4096 + col0; float s = 0.f, q = 0.f;
#pragma unroll
                for (int bj = 0; bj < 2; ++bj) { const f32x4 v0 = acc[ai][bj][m][0], v1 = acc[ai][bj][m][1];
                    const f32x2 a = gelu_pk((f32x2){v0[0], v0[1]}), b = gelu_pk((f32x2){v0[2], v0[3]}), c = gelu_pk((f32x2){v1[0], v1[1]}), d = gelu_pk((f32x2){v1[2], v1[3]});
                    s += (a.x + a.y) + (b.x + b.y) + (c.x + c.y) + (d.x + d.y);
                    q += (a.x * a.x + a.y * a.y) + (b.x * b.x + b.y * b.y) + (c.x * c.x + c.y * c.y) + (d.x * d.x + d.y * d.y);
                    u32x4 w; w.x = cvt_pk_bf16(a.x, a.y); w.y = cvt_pk_bf16(b.x, b.y); w.z = cvt_pk_bf16(c.x, c.y); w.w = cvt_pk_bf16(d.x, d.y);
                    *(u32x4*)(rowp + bj * HALF) = w; }
                if (u.pnl >= 8) { s += __shfl_xor(s, 16); s += __shfl_xor(s, 32); q += __shfl_xor(q, 16); q += __shfl_xor(q, 32);
                    if (fq == 0) *(f32x2*)(ST + ((size_t)row * 32 + (u.pnl - 8) * 4 + wc) * 2) = (f32x2){s, q}; } }
    }
};
struct EpiSwiglu {
    static constexpr bool PERM = true;
    unsigned char* ACT; const float* bgu;
    __device__ __forceinline__ void operator()(const f32x4 (&acc)[2][2][4][2], const Unit& u, int wr, int wc, int fr, int fq) const {
        const int row0 = u.pm * BM + wr * 64 + fr, col0 = u.pnl * HALF + wc * 32 + 8 * fq;
        const float* bp = bgu + (size_t)u.e * 2048 + col0;
        f32x2 bg[4], bu[4];
        { const f32x4 g0 = *(const f32x4*)(bp), g1 = *(const f32x4*)(bp + 4), u0 = *(const f32x4*)(bp + 1024), u1 = *(const f32x4*)(bp + 1028);
          bg[0] = (f32x2){g0[0], g0[1]}; bg[1] = (f32x2){g0[2], g0[3]}; bg[2] = (f32x2){g1[0], g1[1]}; bg[3] = (f32x2){g1[2], g1[3]};
          bu[0] = (f32x2){u0[0], u0[1]} + 1.0f; bu[1] = (f32x2){u0[2], u0[3]} + 1.0f; bu[2] = (f32x2){u1[0], u1[1]} + 1.0f; bu[3] = (f32x2){u1[2], u1[3]} + 1.0f; }
#pragma unroll
        for (int ai = 0; ai < 2; ++ai)
#pragma unroll
            for (int m = 0; m < 4; ++m) { unsigned char* rowp = ACT + (size_t)(row0 + ai * HALF + m * 16) * 1024 + col0;
                f32x2 o[4];
#pragma unroll
                for (int p = 0; p < 4; ++p) { const int n = p >> 1, j0 = 2 * (p & 1);
                    f32x2 g = (f32x2){acc[ai][0][m][n][j0], acc[ai][0][m][n][j0 + 1]} + bg[p], up = (f32x2){acc[ai][1][m][n][j0], acc[ai][1][m][n][j0 + 1]} + bu[p];
                    g.x = fminf(g.x, 7.0f); g.y = fminf(g.y, 7.0f);
                    up.x = __builtin_amdgcn_fmed3f(up.x, -6.0f, 8.0f); up.y = __builtin_amdgcn_fmed3f(up.y, -6.0f, 8.0f);
                    const f32x2 t = g * (-1.702f * 1.44269504f);
                    f32x2 d; d.x = __builtin_amdgcn_exp2f(t.x); d.y = __builtin_amdgcn_exp2f(t.y); d = d + 1.0f;
                    f32x2 r; r.x = __builtin_amdgcn_rcpf(d.x); r.y = __builtin_amdgcn_rcpf(d.y);
                    o[p] = (g * r) * up; }
                int w0 = 0, w1 = 0; w0 = __builtin_amdgcn_cvt_pk_fp8_f32(o[0].x, o[0].y, w0, false); w0 = __builtin_amdgcn_cvt_pk_fp8_f32(o[1].x, o[1].y, w0, true);
                w1 = __builtin_amdgcn_cvt_pk_fp8_f32(o[2].x, o[2].y, w1, false); w1 = __builtin_amdgcn_cvt_pk_fp8_f32(o[3].x, o[3].y, w1, true);
                u32x2 w; w.x = (unsigned)w0; w.y = (unsigned)w1; *(u32x2*)rowp = w; }
    }
};

template <class Epi, class Sched, bool ALIGN_EPI, bool GATHER, bool FP8 = false>
__device__ __forceinline__ void gemm_phase(LAS unsigned char* lds, const Gemm g, const Sched& S, const Epi& E) {
    const int tid = opaque_tid(), wid = __builtin_amdgcn_readfirstlane(tid >> 6), lane = tid & 63, wr = wid >> 2, wc = wid & 3, fr = lane & 15, fq = lane >> 4;
    const int K = g.K, nt = K / 128;
    int scw_ = g.scw, scx_ = 0x7f7f7f7f; if constexpr (FP8) { asm volatile("" : "+v"(scw_), "+v"(scx_)); }
    unsigned voffA[2], voffB[2]; int RA[2]; unsigned cA2[2];
#pragma unroll
    for (int i = 0; i < 2; ++i) { int R, C; stage_rc(tid * 16 + i * 8192, R, C); const int Rb = Epi::PERM ? ((R & ~31) + perm32(R & 31)) : R;
        voffA[i] = (unsigned)(R * K + C * 2); voffB[i] = (unsigned)(Rb * K + C * 2); RA[i] = R; cA2[i] = (unsigned)C * 2u; }
    const size_t kstep = (size_t)(BK * 2);
    const size_t hstepB = (size_t)HALF * K;
    const size_t hstepA = GATHER ? 0 : hstepB;
    const size_t tstep = 2 * hstepB;
    const unsigned ldsw = (unsigned)wid * 1024u;
    const int aoff = lds_byte(wr * 64 + fr, fq * 8), boff = lds_byte(wc * 32 + fr, fq * 8);
#define PG8_SA(b, h) (((b) * 2 + (h)) * HTB)
#define PG8_SB(b, h) ((4 + (b) * 2 + (h)) * HTB)
#define PG8_STAGE2(bufoff, gbase, o0, o1) do { \
        __builtin_amdgcn_global_load_lds((const unsigned*)((const char*)(gbase) + (o0)), (LAS unsigned*)(lds + (bufoff) + ldsw), 16, 0, 0); \
        __builtin_amdgcn_global_load_lds((const unsigned*)((const char*)(gbase) + (o1)), (LAS unsigned*)(lds + (bufoff) + ldsw + 8192), 16, 0, 0); } while (0)
#define PG8_STAGEB(bufoff, gbase) PG8_STAGE2(bufoff, gbase, voffB[0], voffB[1])
#define PG8_LDA(dst, b, h) do { _Pragma("unroll") for (int m = 0; m < 4; ++m) _Pragma("unroll") for (int k = 0; k < 2; ++k) dst[m][k] = *(const LAS bf16x8*)(lds + PG8_SA(b, h) + aoff + m * 2048 + k * 1024); } while (0)
#define PG8_LDB(dst, b, h) do { _Pragma("unroll") for (int n = 0; n < 2; ++n) _Pragma("unroll") for (int k = 0; k < 2; ++k) dst[n][k] = *(const LAS bf16x8*)(lds + PG8_SB(b, h) + boff + n * 2048 + k * 1024); } while (0)
#define PG8_CAT(x, y) __builtin_shufflevector(__builtin_bit_cast(i32x4, x), __builtin_bit_cast(i32x4, y), 0, 1, 2, 3, 4, 5, 6, 7)
#define PG8_MMA(ai, bj, At, Bt) do { if constexpr (FP8) __builtin_amdgcn_sched_barrier(0); __builtin_amdgcn_s_setprio(1); _Pragma("unroll") for (int m = 0; m < 4; ++m) _Pragma("unroll") for (int n = 0; n < 2; ++n) { \
        if constexpr (FP8) { const i32x8 a8_ = PG8_CAT(Bt[n][0], Bt[n][1]), b8_ = PG8_CAT(At[m][0], At[m][1]); \
            asm volatile("v_mfma_scale_f32_16x16x128_f8f6f4 %0, %1, %2, %0, %3, %4 op_sel_hi:[0,0,0]" : "+v"(acc[ai][bj][m][n]) : "v"(a8_), "v"(b8_), "v"(scw_), "v"(scx_)); } \
        else { _Pragma("unroll") for (int k = 0; k < 2; ++k) acc[ai][bj][m][n] = __builtin_amdgcn_mfma_f32_16x16x32_bf16(Bt[n][k], At[m][k], acc[ai][bj][m][n], 0, 0, 0); } } __builtin_amdgcn_s_setprio(0); if constexpr (FP8) __builtin_amdgcn_sched_barrier(0); } while (0)
#define PG8_WAIT_V(n) asm volatile("s_waitcnt vmcnt(" #n ")" ::: "memory")
#define PG8_WAIT_L(n) asm volatile("s_waitcnt lgkmcnt(" #n ")" ::: "memory")
#define PG8_BAR __builtin_amdgcn_s_barrier()
#define PG8_SCHED __builtin_amdgcn_sched_barrier(0)
    LAS int* utab = (LAS int*)(lds + STAGE_BYTES + 2304);
    if (tid < 16) { Unit u_; const bool ok_ = S.next(tid, u_); utab[tid * 4 + 0] = ok_ ? u_.pm : -1; utab[tid * 4 + 1] = u_.pn; utab[tid * 4 + 2] = u_.e; utab[tid * 4 + 3] = u_.pnl; }
    asm volatile("s_waitcnt lgkmcnt(0)" ::: "memory"); __builtin_amdgcn_s_barrier(); asm volatile("" ::: "memory");
#define PG8_NEXT(i_, u_) ((i_) < 16 && (u_.pm = __builtin_amdgcn_readfirstlane(utab[(i_) * 4 + 0])) >= 0 && (u_.pn = __builtin_amdgcn_readfirstlane(utab[(i_) * 4 + 1]), u_.e = __builtin_amdgcn_readfirstlane(utab[(i_) * 4 + 2]), u_.pnl = __builtin_amdgcn_readfirstlane(utab[(i_) * 4 + 3]), true))
    Unit cur, nxt; int ui = 0;
    if (!PG8_NEXT(0, cur)) return;
    f32x4 acc[2][2][4][2];
#pragma unroll
    for (int a = 0; a < 2; ++a)
#pragma unroll
        for (int b = 0; b < 2; ++b)
#pragma unroll
            for (int m = 0; m < 4; ++m)
#pragma unroll
                for (int n = 0; n < 2; ++n) acc[a][b][m][n] = (f32x4){0.f, 0.f, 0.f, 0.f};
    bf16x8 At[4][2], B0[2][2], B1[2][2];
    unsigned gC[2][2], gN[2][2];
#pragma unroll
    for (int h = 0; h < 2; ++h)
#pragma unroll
        for (int i = 0; i < 2; ++i) { gC[h][i] = GATHER ? ((unsigned)S.rowidx(0, h * HALF + RA[i]) * (unsigned)K + cA2[i]) : voffA[i]; gN[h][i] = gC[h][i]; }
    const char* cA = GATHER ? (const char*)g.A : (const char*)g.A + (size_t)cur.pm * tstep; const char* cB = (const char*)g.Bt + (size_t)cur.pn * tstep;
    PG8_STAGEB(PG8_SB(0, 0), cB); PG8_STAGEB(PG8_SB(0, 1), cB + hstepB); PG8_STAGE2(PG8_SA(0, 0), cA, gC[0][0], gC[0][1]); PG8_STAGE2(PG8_SA(0, 1), cA + hstepA, gC[1][0], gC[1][1]);
    if (wr == 1) PG8_BAR;
    PG8_WAIT_V(2); PG8_BAR;
    PG8_STAGEB(PG8_SB(1, 0), cB + kstep); PG8_STAGE2(PG8_SA(1, 0), cA + kstep, gC[0][0], gC[0][1]); PG8_STAGEB(PG8_SB(1, 1), cB + hstepB + kstep);
    PG8_WAIT_V(6); PG8_BAR;
    for (;;) {
        const bool has_next = PG8_NEXT(ui + 1, nxt);
        const char* nA = GATHER ? cA : (has_next ? (const char*)g.A + (size_t)nxt.pm * tstep : cA); const char* nB = has_next ? (const char*)g.Bt + (size_t)nxt.pn * tstep : cB;
        if (GATHER) {
#pragma unroll
            for (int h = 0; h < 2; ++h)
#pragma unroll
                for (int i = 0; i < 2; ++i) gN[h][i] = has_next ? ((unsigned)S.rowidx(ui + 1, h * HALF + RA[i]) * (unsigned)K + cA2[i]) : gC[h][i];
        }
#pragma unroll 1
        for (int t = 0; t < nt; t += 2) {
            const bool last = (t == nt - 2);
            const char* a1 = cA + (size_t)(t + 1) * kstep;
            const char* a2 = last ? nA : cA + (size_t)(t + 2) * kstep; const char* b2 = last ? nB : cB + (size_t)(t + 2) * kstep;
            const char* a3 = a2 + kstep; const char* b3 = b2 + kstep;
            unsigned x00, x01, x10, x11;
            if (GATHER) { x00 = last ? gN[0][0] : gC[0][0]; x01 = last ? gN[0][1] : gC[0][1]; x10 = last ? gN[1][0] : gC[1][0]; x11 = last ? gN[1][1] : gC[1][1]; }
            else { x00 = voffA[0]; x01 = voffA[1]; x10 = voffA[0]; x11 = voffA[1]; }
            PG8_LDB(B0, 0, 0); PG8_LDB(B1, 0, 1); PG8_SCHED; PG8_LDA(At, 0, 0); PG8_STAGE2(PG8_SA(1, 1), a1 + hstepA, gC[1][0], gC[1][1]);
            PG8_WAIT_V(8); PG8_WAIT_L(0); PG8_BAR; PG8_MMA(0, 0, At, B0); PG8_MMA(0, 1, At, B1); PG8_BAR; PG8_SCHED;
            PG8_LDA(At, 0, 1); PG8_STAGEB(PG8_SB(0, 0), b2); PG8_STAGEB(PG8_SB(0, 1), b2 + hstepB); PG8_STAGE2(PG8_SA(0, 0), a2, x00, x01);
            PG8_WAIT_V(8); PG8_WAIT_L(0); PG8_BAR; PG8_MMA(1, 0, At, B0); PG8_MMA(1, 1, At, B1); PG8_BAR; PG8_SCHED;
            PG8_LDB(B0, 1, 0); PG8_LDB(B1, 1, 1); PG8_SCHED; PG8_LDA(At, 1, 0); PG8_STAGE2(PG8_SA(0, 1), a2 + hstepA, x10, x11);
            PG8_WAIT_V(8); PG8_WAIT_L(0); PG8_BAR; PG8_MMA(0, 0, At, B0); PG8_MMA(0, 1, At, B1); PG8_BAR; PG8_SCHED;
            PG8_LDA(At, 1, 1); PG8_STAGEB(PG8_SB(1, 0), b3); PG8_STAGEB(PG8_SB(1, 1), b3 + hstepB); PG8_STAGE2(PG8_SA(1, 0), a3, x00, x01);
            PG8_WAIT_V(8); PG8_WAIT_L(0); PG8_BAR; PG8_MMA(1, 0, At, B0); PG8_MMA(1, 1, At, B1); PG8_BAR; PG8_SCHED;
            if (GATHER && last) {
#pragma unroll
                for (int h = 0; h < 2; ++h)
#pragma unroll
                    for (int i = 0; i < 2; ++i) gC[h][i] = gN[h][i];
            }
        }
        if constexpr (ALIGN_EPI) { if (wr == 0) PG8_BAR; }
        if constexpr (FP8) asm volatile("s_nop 15\n\ts_nop 15" ::: "memory");
        E(acc, cur, wr, wc, fr, fq);
        if (!has_next) break;
#pragma unroll
        for (int a = 0; a < 2; ++a)
#pragma unroll
            for (int b = 0; b < 2; ++b)
#pragma unroll
                for (int m = 0; m < 4; ++m)
#pragma unroll
                    for (int n = 0; n < 2; ++n) acc[a][b][m][n] = (f32x4){0.f, 0.f, 0.f, 0.f};
        cur = nxt; cA = nA; cB = nB; ++ui;
        if constexpr (ALIGN_EPI) { if (wr == 1) PG8_BAR; }
    }
    PG8_WAIT_V(0);
    if constexpr (!ALIGN_EPI) { if (wr == 0) PG8_BAR; }
    PG8_BAR;
#undef PG8_SA
#undef PG8_SB
#undef PG8_STAGE2
#undef PG8_STAGEB
#undef PG8_LDA
#undef PG8_LDB
#undef PG8_MMA
#undef PG8_NEXT
#undef PG8_CAT
#undef PG8_WAIT_V
#undef PG8_WAIT_L
#undef PG8_BAR
#undef PG8_SCHED
}
}

#define XB_TMO      128
#define XB_MIS      192
#define XB_XCNT(j)  (256  + 64 * (j))
#define XB_XSUB(j)  (1280 + 64 * (j))
#define XB_XGEN(j)  (2304 + 64 * (j))
#define XB_TOP      3328
#define XB_TOPGEN   3392
#define XCD_BAR_WORDS 3456
#define XB_SPIN_CAP (1u << 18)
__device__ __forceinline__ unsigned xb_ld(unsigned* p)              { return __hip_atomic_load(p, __ATOMIC_RELAXED, __HIP_MEMORY_SCOPE_AGENT); }
__device__ __forceinline__ unsigned xb_add(unsigned* p, unsigned v) { return __hip_atomic_fetch_add(p, v, __ATOMIC_RELAXED, __HIP_MEMORY_SCOPE_AGENT); }
__device__ __forceinline__ unsigned xb_xcc_id() { return (unsigned)__builtin_amdgcn_s_getreg((3 << 11) | 20) & 0xFu; }
#define XB_SPIN(cond, bar) do { unsigned _sp = 0; while (cond) { __builtin_amdgcn_s_sleep(1); \
    if ((++_sp & 255u) == 0u) { if (xb_ld(&(bar)[XB_TMO])) break; if (_sp > XB_SPIN_CAP) { atomicAdd(&(bar)[XB_TMO], 1u); break; } } } } while (0)
struct XcdBarrier { unsigned* bar; unsigned x; volatile LAS unsigned* st; };
__device__ __forceinline__ XcdBarrier xcd_barrier_post(unsigned* bar, volatile LAS unsigned* st) {
    XcdBarrier b; b.bar = bar; b.x = xb_xcc_id(); b.st = st;
    if (threadIdx.x == 0) (void)xb_add(&bar[XB_XCNT(b.x)], 1u);
    return b;
}
__device__ __forceinline__ void xcd_barrier_complete(unsigned* bar, unsigned x, unsigned& nloc, unsigned& nx) {
    const unsigned G = gridDim.x * gridDim.y * gridDim.z;
    unsigned sum, cnt, mine, sp = 0u;
    for (;;) {
        sum = 0u; cnt = 0u; mine = 0u;
#pragma unroll
        for (unsigned j = 0; j < 16; ++j) { const unsigned c = xb_ld(&bar[XB_XCNT(j)]); sum += c; cnt += (c > 0u) ? 1u : 0u; mine = (j == x) ? c : mine; }
        if (sum == G) break;
        __builtin_amdgcn_s_sleep(1);
        if ((++sp & 255u) == 0u) { if (xb_ld(&bar[XB_TMO])) break; if (sp > XB_SPIN_CAP) { atomicAdd(&bar[XB_TMO], 1u); break; } }
    }
    nloc = mine > 0u ? mine : 1u; nx = cnt > 0u ? cnt : 1u;
}
__device__ __noinline__ void xcd_barrier(unsigned* bbar, unsigned bx_, volatile LAS unsigned* bst) {
    XcdBarrier b; b.bar = bbar; b.x = bx_; b.st = bst;
    asm volatile("s_waitcnt vmcnt(0)" ::: "memory");
    __syncthreads();
    if (threadIdx.x == 0) {
        unsigned* bar = b.bar;
        __builtin_amdgcn_s_waitcnt(0);
        unsigned nloc = b.st[0], nx = b.st[1];
        if (nloc == 0u) { xcd_barrier_complete(bar, b.x, nloc, nx); b.st[0] = nloc; b.st[1] = nx; }
        const unsigned old = xb_add(&bar[XB_XSUB(b.x)], 1u);
        const unsigned gen = old / nloc;
        if (old + 1u == (gen + 1u) * nloc) {
            __builtin_amdgcn_fence(__ATOMIC_RELEASE, "agent");
            asm volatile("s_waitcnt vmcnt(0)" ::: "memory");
            const unsigned og = xb_add(&bar[XB_TOP], 1u);
            const unsigned tg = og / nx;
            if (og + 1u == (tg + 1u) * nx) xb_add(&bar[XB_TOPGEN], 1u);
            else XB_SPIN(xb_ld(&bar[XB_TOPGEN]) == tg, bar);
            __builtin_amdgcn_fence(__ATOMIC_ACQUIRE, "agent");
            xb_add(&bar[XB_XGEN(b.x)], 1u);
            asm volatile("s_waitcnt vmcnt(0)" ::: "memory");
        } else {
            XB_SPIN(xb_ld(&bar[XB_XGEN(b.x)]) == gen, bar);
            __builtin_amdgcn_fence(__ATOMIC_ACQUIRE, "agent");
            asm volatile("s_waitcnt vmcnt(0)" ::: "memory");
        }
    }
    __syncthreads();
}

struct ConvItem { const float* src; bf16* dst; };
__device__ __forceinline__ void conv_load(f32x4 (&v)[8], const float* W, int Nsrc, int k0, int n0, int lane) {
    const float* p = W + (size_t)(k0 + 8 * (lane >> 3)) * Nsrc + n0 + 4 * (lane & 7);
#pragma unroll
    for (int i = 0; i < 8; ++i) v[i] = __builtin_nontemporal_load((const f32x4*)(p + (size_t)i * Nsrc));
}
__device__ __forceinline__ void conv_store(const f32x4 (&v)[8], bf16* WT, int K, int drow0, int k0, int lane) {
    bf16* q = WT + (size_t)(drow0 + 4 * (lane & 7)) * K + k0 + 8 * (lane >> 3);
#pragma unroll
    for (int e = 0; e < 4; ++e) { u32x4 o; o.x = cvt_pk_bf16(v[0][e], v[1][e]); o.y = cvt_pk_bf16(v[2][e], v[3][e]); o.z = cvt_pk_bf16(v[4][e], v[5][e]); o.w = cvt_pk_bf16(v[6][e], v[7][e]);
        __builtin_nontemporal_store(o, (u32x4*)(q + (size_t)e * K)); }
}
__device__ __forceinline__ void conv_decode(int it, int K, int Nsrc, int Nc, bool gu, const float* W, bf16* WT, const float*& src, bf16*& dst, int& k0, int& n0, int& drow0) {
    const int nblk = Nc / 32, per = nblk * (K / 64), mat = it / per, r = it % per; k0 = (r / nblk) * 64; n0 = (r % nblk) * 32;
    drow0 = gu ? (256 * ((n0 & 1023) >> 7) + 128 * (n0 >> 10) + (n0 & 127)) : n0; src = W + (size_t)mat * K * Nsrc; dst = WT + (size_t)mat * Nc * K;
}
__device__ __forceinline__ void conv_range(const float* W, int K, int Nsrc, int Nc, bf16* WT, bool gu, int it0, int it1, int stride, int lane) {
    for (int it = it0; it < it1; it += 4 * stride) {
        f32x4 v[4][8]; const float* src[4]; bf16* dst[4]; int k0[4], n0[4], dr[4];
#pragma unroll
        for (int q = 0; q < 4; ++q) { const int iq = it + q * stride; if (iq < it1) { conv_decode(iq, K, Nsrc, Nc, gu, W, WT, src[q], dst[q], k0[q], n0[q], dr[q]); conv_load(v[q], src[q], Nsrc, k0[q], n0[q], lane); } }
#pragma unroll
        for (int q = 0; q < 4; ++q) { const int iq = it + q * stride; if (iq < it1) conv_store(v[q], dst[q], K, dr[q], k0[q], lane); }
    }
}
__device__ __forceinline__ void conv_mats(const float* W, int nmat, int K, int Nsrc, int Nc, bf16* WT, bool gu, int gw, int NGW, int lane) {
    conv_range(W, K, Nsrc, Nc, WT, gu, gw, nmat * (Nc / 32) * (K / 64), NGW, lane);
}
constexpr int CONV_TOTAL = 24576, CONV_X = 4096;
__device__ __forceinline__ void conv_fp8(const float* W, unsigned char* WT, int N, int it, bool gu, float mul, int lane, int Nsrc = 0, int K = D) {
    const int nblk = N >> 5, per = nblk * (K >> 7), mat = it / per, r = it % per, k0 = (r / nblk) << 7, n0 = (r % nblk) << 5;
    const int drow0 = gu ? (256 * ((n0 & 1023) >> 7) + 128 * (n0 >> 10) + (n0 & 127)) : n0;
    const int Ns = Nsrc ? Nsrc : N;
    const float* p = W + (size_t)mat * K * Ns + (size_t)(k0 + 16 * (lane >> 3)) * Ns + n0 + 4 * (lane & 7);
    unsigned char* q = WT + (size_t)mat * N * K + (size_t)(drow0 + 4 * (lane & 7)) * K + k0 + 16 * (lane >> 3);
    f32x4 v[16];
#pragma unroll
    for (int i = 0; i < 16; ++i) v[i] = __builtin_nontemporal_load((const f32x4*)(p + (size_t)i * Ns)) * mul;
#pragma unroll
    for (int e = 0; e < 4; ++e) { i32x4 o;
#pragma unroll
        for (int w = 0; w < 4; ++w) { int x = 0; x = __builtin_amdgcn_cvt_pk_fp8_f32(v[4 * w][e], v[4 * w + 1][e], x, false); x = __builtin_amdgcn_cvt_pk_fp8_f32(v[4 * w + 2][e], v[4 * w + 3][e], x, true); o[w] = x; }
        __builtin_nontemporal_store(o, (i32x4*)(q + (size_t)e * K)); }
}
__device__ __forceinline__ void conv_unified(const float* gu, const float* dn, bf16* gut, bf16* dnt, int u0, int u1, int lane) {
    for (int u = u0; u < u1; ++u) { const int q3 = u / 3, r3 = u - 3 * q3;
        if (r3 < 2) conv_fp8(gu, (unsigned char*)gut, 2048, q3 * 2 + r3, true, (float)(1 << FP8_GU_SHIFT), lane);
        else conv_fp8(dn, (unsigned char*)dnt, D, q3, false, (float)(1 << FP8_DN_SHIFT), lane); }
}
__device__ __forceinline__ void conv_wg_range(const float* gu, const float* dn, bf16* gut, bf16* dnt, int w0, int w1, int wave, int lane) {
    const int len = w1 - w0; if (len <= 0) return; const int per = (len + NWAVES - 1) / NWAVES; const int a0 = w0 + wave * per, a1 = (a0 + per < w1) ? a0 + per : w1;
    if (a0 < a1) conv_unified(gu, dn, gut, dnt, a0, a1, lane);
}
__device__ __forceinline__ void conv_static(const float* gu, const float* dn, bf16* gut, bf16* dnt, gu32* cur, int x, int bx, int wave, int lane) {
    if (x > 0) { int c0 = (int)__hip_atomic_load((unsigned*)cur, __ATOMIC_RELAXED, __HIP_MEMORY_SCOPE_AGENT); c0 = c0 < x ? c0 : x; const int lw = (x - c0 + 255) >> 8;
        const int l0 = c0 + bx * lw, l1 = (l0 + lw < x) ? l0 + lw : x; conv_wg_range(gu, dn, gut, dnt, l0, l1, wave, lane); }
    const int ds = (CONV_TOTAL - x) >> 8; conv_wg_range(gu, dn, gut, dnt, x + bx * ds, x + (bx + 1) * ds, wave, lane);
}
__device__ __forceinline__ void conv_grab(const float* gu, const float* dn, bf16* gut, bf16* dnt, gu32* cur, int n, int lane) {
    unsigned base = 0; if (lane == 0) base = __hip_atomic_fetch_add((unsigned*)cur, (unsigned)n, __ATOMIC_RELAXED, __HIP_MEMORY_SCOPE_AGENT);
    base = __builtin_amdgcn_readfirstlane(base); if (base >= (unsigned)CONV_X) return;
    conv_unified(gu, dn, gut, dnt, (int)base, ((int)base + n < CONV_X) ? (int)base + n : CONV_X, lane);
}
#define MOE_GU(l)  (IN_(19) + (size_t)(l) * NE * D * 2048)
#define MOE_DN(l)  (IN_(21) + (size_t)(l) * NE * D * D)
#define MOE_GUT(l) ((bf16*)((unsigned char*)(WSP + WS_GU) + (size_t)(l) * NE * 2048 * D))
#define MOE_DNT(l) ((bf16*)((unsigned char*)(WSP + WS_DN) + (size_t)(l) * NE * D * D))
#define CONV_CUR(l) (CTL + CW_CV + (l) * 64)

__device__ __forceinline__ int t5_bucket(int n) {
    if (n < 16) return n;
    const float v = (logf((float)n / 16.0f) / 2.0794415416798357f) * 16.0f;
    const int large = 16 + (int)v;
    return large < 31 ? large : 31;
}

struct Args { const float* in[23]; float* out; unsigned char* ws; int ph_lo, ph_hi; };

typedef __attribute__((address_space(4))) const Args CArgs;
__device__ __forceinline__ CArgs* opaque_args() { CArgs* p = (CArgs*)__builtin_amdgcn_kernarg_segment_ptr(); asm volatile("" : "+s"(p)); return p; }
#define IN_(i)  (ap->in[i])
#define WSP     ((unsigned char*)ap->ws)
#define Hf      ((float*)ap->out)
#define HB      ((bf16*)(WSP + WS_HB))
#define UB      ((bf16*)(WSP + WS_U))
#define HB8     ((unsigned char*)(WSP + WS_U + 32 * MiB))
#define BIG1    ((bf16*)(WSP + WS_BIG1))
#define BIG2    ((bf16*)(WSP + WS_BIG2))
#define BIG3    ((float*)(WSP + WS_BIG3))
#define ACT     ((bf16*)(WSP + WS_ACT))
#define YS      ((bf16*)(WSP + WS_YS))
#define TOK     ((int*)(WSP + WS_TOK))
#define SELE    ((int*)(WSP + WS_SELE))
#define SELP    ((int*)(WSP + WS_SELP))
#define SELG    ((float*)(WSP + WS_SELG))
#define KMEAN   ((float*)(WSP + WS_KMEAN))
#define STATS   ((float*)(WSP + WS_STATS))
#define WRH     ((bf16*)(WSP + WS_WRT))
#define WRL     ((bf16*)(WSP + WS_WRT + 256 * 1024))
#define W16T    ((float*)(WSP + WS_W16T))
#define GKL     ((float*)(WSP + WS_GKL))
#define CTL     ((gu32*)(WSP + WS_CTL))

#define PH_BEGIN if (lo <= pid && pid < hi) for (int rep_ = 0; rep_ < ((((unsigned long long)PROBE_MASK >> pid) & 1ull) ? 2 : 1); ++rep_) { const int tid = opaque_tid(), lane = tid & 63, wave = __builtin_amdgcn_readfirstlane(tid >> 6), gw = bx * NWAVES + wave, NGW = G * NWAVES; CArgs* ap = opaque_args(); (void)lane; (void)gw; (void)NGW; (void)ap;
#define cursor  (CTL + CW_CNT + layer * 64)
#define OB      BIG3
#define LOGA    (BIG3 + (size_t)T * 1024)
#define GQE     ((bf16*)(BIG3 + (size_t)T * 1536))
#define GDEC    (BIG3 + (size_t)T * 1536 + (size_t)T * 256)
#define PH_END } if (lo <= pid && pid + 1 < hi) xcd_barrier_work(bar.bar, bar.x, bar.st, (unsigned)(pid + 1), opaque_args()); ++pid;


constexpr unsigned long long LOCAL_SEAMS = (1ull << 6) | (1ull << 13) | (1ull << 22) | (1ull << 29) | (1ull << 2) | (1ull << 3) | (1ull << 4) | (1ull << 8) | (1ull << 9) | (1ull << 10) | (1ull << 11) | (1ull << 15) | (1ull << 16) | (1ull << 17) | (1ull << 18) | (1ull << 19) | (1ull << 20)
                                         | (1ull << 24) | (1ull << 25) | (1ull << 26) | (1ull << 27);
constexpr int CW_WQ = 14336;
constexpr int WQ_PER_LAYER = CONV_TOTAL / 8;
__device__ __forceinline__ bool wq_grab_convert(CArgs* ap, unsigned x, int lane, unsigned& base) {
    unsigned b0 = 0; if (lane == 0) b0 = __hip_atomic_fetch_add((unsigned*)(CTL + CW_WQ + 64 * x), 2u, __ATOMIC_RELAXED, __HIP_MEMORY_SCOPE_AGENT);
    base = (unsigned)__builtin_amdgcn_readfirstlane((int)b0);
    if (base >= (unsigned)(NLAYER * WQ_PER_LAYER)) return false;
    const int wl = (int)base / WQ_PER_LAYER, u = (int)x * WQ_PER_LAYER + (int)base % WQ_PER_LAYER;
    conv_unified(MOE_GU(wl), MOE_DN(wl), MOE_GUT(wl), MOE_DNT(wl), u, u + 2, lane);
    return true;
}
__device__ __forceinline__ void wq_drain(CArgs* ap, int wl, int lane) {
    const unsigned x = xb_xcc_id() & 7u;
    for (;;) { unsigned base; if (!wq_grab_convert(ap, x, lane, base)) break; if (base >= (unsigned)((wl + 1) * WQ_PER_LAYER)) break; }
}
__device__ __forceinline__ void xcd_barrier_work(unsigned* bbar, unsigned bx_, volatile LAS unsigned* bst, unsigned seq, CArgs* ap) {
    XcdBarrier b; b.bar = bbar; b.x = bx_; b.st = bst;
    asm volatile("s_waitcnt vmcnt(0)" ::: "memory");
    __syncthreads();
    const int tid = threadIdx.x, lane = tid & 63, wave = __builtin_amdgcn_readfirstlane(tid >> 6);
    if (tid == 0) {
        unsigned* bar = b.bar;
        __builtin_amdgcn_s_waitcnt(0);
        unsigned nloc = b.st[0], nx = b.st[1];
        if (nloc == 0u) { xcd_barrier_complete(bar, b.x, nloc, nx); b.st[0] = nloc; b.st[1] = nx; }
        const unsigned old = xb_add(&bar[XB_XSUB(b.x)], 1u);
        const unsigned gen = old / nloc;
        const bool leader = (old + 1u == (gen + 1u) * nloc);
        bst[3] = seq * 4u + (leader ? 1u : 2u);
        const bool local_ = ((LOCAL_SEAMS >> seq) & 1ull) != 0ull && bst[8] == 1u;
        if (leader) {
            if (!local_) {
                __builtin_amdgcn_fence(__ATOMIC_RELEASE, "agent");
                asm volatile("s_waitcnt vmcnt(0)" ::: "memory");
                const unsigned og = xb_add(&bar[XB_TOP], 1u);
                const unsigned tg = og / nx;
                if (og + 1u == (tg + 1u) * nx) xb_add(&bar[XB_TOPGEN], 1u);
                else XB_SPIN(xb_ld(&bar[XB_TOPGEN]) == tg, bar);
            }
            __builtin_amdgcn_fence(__ATOMIC_ACQUIRE, "agent");
            xb_add(&bar[XB_XGEN(b.x)], 1u);
            asm volatile("s_waitcnt vmcnt(0)" ::: "memory");
        } else {
            XB_SPIN(xb_ld(&bar[XB_XGEN(b.x)]) == gen, bar);
            __builtin_amdgcn_fence(__ATOMIC_ACQUIRE, "agent");
            asm volatile("s_waitcnt vmcnt(0)" ::: "memory");
        }
        if (seq == 1u) bst[8] = (xb_ld(&bar[XB_MIS]) == 0u) ? 1u : 0u;
        bst[2] = seq;
    } else if (wave != 0) {
        unsigned r = 0, sp = 0;
        while ((((r = bst[3])) >> 2) != seq) { __builtin_amdgcn_s_sleep(1); if (++sp > (1u << 22)) break; }
        if ((r & 3u) == 2u) {
            const unsigned x = xb_xcc_id() & 7u; sp = 0;
            while (bst[2] != seq) {
                if (bst[6] == 0u) { unsigned base; if (!wq_grab_convert(ap, x, lane, base)) bst[6] = 1u; }
                else { __builtin_amdgcn_s_sleep(8); if (++sp > (1u << 22)) break; }
            }
        }
    }
    __syncthreads();
}

__device__ __forceinline__ void glds16(const void* gsrc, unsigned lds_dst) { unsigned keep;
    asm volatile("s_mov_b32 %0, m0\n\ts_mov_b32 m0, %2\n\ts_nop 0\n\tglobal_load_lds_dwordx4 %1, off\n\ts_mov_b32 m0, %0" : "=&s"(keep) : "v"(gsrc), "s"(lds_dst) : "memory"); }
#define LDS_ADDR(p) ((unsigned)__builtin_amdgcn_readfirstlane((int)(unsigned)(size_t)(p)))
typedef float f32x16 __attribute__((ext_vector_type(16)));
typedef short s16x4 __attribute__((ext_vector_type(4)));
typedef short v4i16_t __attribute__((ext_vector_type(4)));
typedef __bf16 bf16x2_t __attribute__((ext_vector_type(2)));
__device__ __forceinline__ unsigned pk_bf16(float lo, float hi) { f32x2 v = {lo, hi}; bf16x2_t b = __builtin_convertvector(v, bf16x2_t); return __builtin_bit_cast(unsigned, b); }
__device__ __forceinline__ unsigned off_b(unsigned row, unsigned ch) { return 256u * row + 16u * (ch ^ (((row & 3u) << 2) | ((row >> 2) & 3u))); }
__device__ __forceinline__ s16x4 lds_tr(LAS unsigned char* p) { return __builtin_bit_cast(s16x4, __builtin_amdgcn_ds_read_tr16_b64_v4i16((LAS v4i16_t*)p)); }

__device__ __forceinline__ void attn_phase(LAS unsigned char* lds, const bf16* QKV, bf16* O, const float* relb, const float* KP, const int G, const int bx, const int tid) {
    constexpr int KB0 = 0, VB0 = 16384, KM_OFF = 114688, GT_OFF = 118784, SEL_OFF = 126976, TAB_OFF = 128000;
    constexpr float C1 = 0.08838834764831845f * 1.4426950408889634f, LOG2E = 1.4426950408889634f;
    const int lane = tid & 63, wave = __builtin_amdgcn_readfirstlane(tid >> 6), r32 = lane & 31, h2 = lane >> 5;
    LAS float* KM = (LAS float*)(lds + KM_OFF); LAS float* GT = (LAS float*)(lds + GT_OFF); LAS int* SELB = (LAS int*)(lds + SEL_OFF); LAS float* TAB = (LAS float*)(lds + TAB_OFF);
    const int vcu = (G % 8 == 0) ? (bx % 8) * (G / 8) + bx / 8 : bx;
    for (int pp_ = vcu; pp_ < 256 * ATT_REP; pp_ += G) { const int p = pp_ & 255;
    for (int uu = 0; uu < 2; ++uu) {
        const int bh = p >> 2, ol = p & 3, o = (uu == 0) ? (7 - ol) : ol, b = bh >> 3, h = bh & 7;
        const size_t tok0 = (size_t)b * SEQ;
        if (tid < 128) TAB[tid] = relb[t5_bucket(tid) * AH + h] * LOG2E;
        if (o > 3) {
            int tz = tid; asm volatile("" : "+v"(tz));
            for (int i = tz; i < o * 128; i += NTHR) { const int n = i >> 7, d = i & 127; const float* kp = KP + ((size_t)(b * 8 + n) * 2) * 1024 + h * 128 + d;
                KM[i] = (kp[0] + kp[1024]) * (1.0f / 256.0f); }
        }
        __syncthreads();
        if (o > 3) {
            const int qi = tid & 255, part = tid >> 8;
            const bf16* qrow = QKV + (tok0 + o * 256 + qi) * 3072 + h * 128;
            float ga[4] = {0.f, 0.f, 0.f, 0.f};
            u32x4 qa[16];
#pragma unroll
            for (int c = 0; c < 16; ++c) qa[c] = *(const u32x4*)(qrow + c * 8);
#pragma unroll
            for (int c = 0; c < 16; ++c) { const u32x4 qv = qa[c];
                const float q8[8] = {__uint_as_float(qv.x << 16), __uint_as_float(qv.x & 0xffff0000u), __uint_as_float(qv.y << 16), __uint_as_float(qv.y & 0xffff0000u),
                                     __uint_as_float(qv.z << 16), __uint_as_float(qv.z & 0xffff0000u), __uint_as_float(qv.w << 16), __uint_as_float(qv.w & 0xffff0000u)};
#pragma unroll
                for (int k = 0; k < 4; ++k) { const int n = part + 2 * k; if (n < o) { const f32x4 k0 = *(const LAS f32x4*)(KM + n * 128 + c * 8), k1 = *(const LAS f32x4*)(KM + n * 128 + c * 8 + 4);
                    ga[k] += (q8[0] * k0[0] + q8[1] * k0[1]) + (q8[2] * k0[2] + q8[3] * k0[3]) + (q8[4] * k1[0] + q8[5] * k1[1]) + (q8[6] * k1[2] + q8[7] * k1[3]); } } }
#pragma unroll
            for (int k = 0; k < 4; ++k) { const int n = part + 2 * k; if (n < o) GT[qi * 8 + n] = ga[k]; }
            __syncthreads();
            if (tid < 256) { unsigned sel = 0u;
#pragma unroll
                for (int r = 0; r < 3; ++r) { float best = -INFINITY; int bi = -1;
                    for (int n = 0; n < o; ++n) { const float gv = GT[tid * 8 + n]; if (!((sel >> n) & 1u) && gv > best) { best = gv; bi = n; } }
                    if (bi >= 0) sel |= 1u << bi; }
                SELB[tid] = (int)sel; }
        } else { if (tid < 256) SELB[tid] = (1 << o) - 1; }
        __syncthreads();
        const int qloc = 32 * wave + r32, qpos = o * 256 + qloc;
        bf16x8 qf[8];
        { const bf16* qrow = QKV + (tok0 + qpos) * 3072 + h * 128 + 8 * h2;
#pragma unroll
          for (int ks = 0; ks < 8; ++ks) qf[ks] = *(const bf16x8*)(qrow + 16 * ks); }
        const unsigned selb = (unsigned)SELB[qloc];
        float m = -1e30f, l = 0.f;
        f32x16 oacc[4];
#pragma unroll
        for (int dt = 0; dt < 4; ++dt)
#pragma unroll
            for (int i = 0; i < 16; ++i) oacc[dt][i] = 0.f;
        const int ntiles = 4 * (o + 1);
        unsigned goff[2];
#pragma unroll
        for (int jj = 0; jj < 2; ++jj) { const unsigned row = 8 * wave + 4 * jj + (lane >> 4), cl = lane & 15, ch = cl ^ (((row & 3u) << 2) | ((row >> 2) & 3u)); goff[jj] = row * 6144u + ch * 16u; }
#define ATT_STAGE(bufo, nn, tt) do { const char* kp_ = (const char*)(QKV + (tok0 + (nn) * 256 + (tt) * 64) * 3072 + 1024 + h * 128); \
            _Pragma("unroll") for (int jj = 0; jj < 2; ++jj) { \
                glds16(kp_ + goff[jj], LDS_ADDR(lds + (bufo) + KB0 + (8 * wave + 4 * jj) * 256)); \
                glds16(kp_ + 2048 + goff[jj], LDS_ADDR(lds + (bufo) + VB0 + (8 * wave + 4 * jj) * 256)); } } while (0)
        ATT_STAGE(0, o, 0);
        ATT_STAGE(32768, o, 1);
        asm volatile("s_waitcnt vmcnt(4)" ::: "memory"); __builtin_amdgcn_s_barrier(); asm volatile("" ::: "memory");
        int slot = 0;
        for (int it = 0; it < ntiles; ++it) {
            const int n = (it < 4) ? o : (o - 1 - ((it - 4) >> 2)), t = it & 3;
            const int buf = slot * 32768;
            if (it + 2 < ntiles) { const int n2 = (it + 2 < 4) ? o : (o - 1 - ((it + 2 - 4) >> 2)), t2 = (it + 2) & 3; const int s2 = (slot >= 1) ? slot - 1 : 2; ATT_STAGE(s2 * 32768, n2, t2); }
            const bool own = (n == o);
            const bool active = !own || (64 * t <= 32 * wave + 31);
            if (active) {
                f32x16 S[2];
#pragma unroll
                for (int i = 0; i < 16; ++i) { S[0][i] = 0.f; S[1][i] = 0.f; }
#pragma unroll
                for (int ks = 0; ks < 8; ++ks) {
                    const bf16x8 k0 = *(const LAS bf16x8*)(lds + buf + KB0 + off_b(r32, 2 * ks + h2)), k1 = *(const LAS bf16x8*)(lds + buf + KB0 + off_b(32 + r32, 2 * ks + h2));
                    S[0] = __builtin_amdgcn_mfma_f32_32x32x16_bf16(k0, qf[ks], S[0], 0, 0, 0);
                    S[1] = __builtin_amdgcn_mfma_f32_32x32x16_bf16(k1, qf[ks], S[1], 0, 0, 0);
                }
                const int dq = qpos - (n * 256 + 64 * t) - 4 * h2;
                const bool lanesel = own || ((selb >> n) & 1u);
                const bool neartab = own || (32 * wave - 64 * t + 256 * (o - n) - 63 < 113);
                float mx = -INFINITY;
                if (neartab) {
#pragma unroll
                    for (int kt = 0; kt < 2; ++kt)
#pragma unroll
                        for (int i = 0; i < 16; ++i) { const int dist = dq - (32 * kt + (i & 3) + 8 * (i >> 2));
                            const float bias = TAB[dist < 0 ? 0 : (dist > 127 ? 127 : dist)];
                            const float sv = (lanesel && dist >= 0) ? (S[kt][i] * C1 + bias) : -INFINITY; S[kt][i] = sv; mx = fmaxf(mx, sv); }
                } else {
                    const float bias = TAB[127];
#pragma unroll
                    for (int kt = 0; kt < 2; ++kt)
#pragma unroll
                        for (int i = 0; i < 16; ++i) { const float sv = lanesel ? (S[kt][i] * C1 + bias) : -INFINITY; S[kt][i] = sv; mx = fmaxf(mx, sv); }
                }
                mx = fmaxf(mx, __shfl_xor(mx, 32));
                const float mn = fmaxf(m, mx), alpha = __builtin_amdgcn_exp2f(m - mn);
                m = mn;
                float ps = 0.f;
#pragma unroll
                for (int kt = 0; kt < 2; ++kt)
#pragma unroll
                    for (int i = 0; i < 16; ++i) { const float pv = __builtin_amdgcn_exp2f(S[kt][i] - mn); S[kt][i] = pv; ps += pv; }
                l = l * alpha + ps;
                if (__builtin_amdgcn_ballot_w64(alpha != 1.0f) != 0ull) {
#pragma unroll
                    for (int dt = 0; dt < 4; ++dt)
#pragma unroll
                        for (int i = 0; i < 16; ++i) oacc[dt][i] *= alpha; }
                bf16x8 pf[2][2];
#pragma unroll
                for (int kt = 0; kt < 2; ++kt)
#pragma unroll
                    for (int s2 = 0; s2 < 2; ++s2) { u32x4 w; w.x = pk_bf16(S[kt][8 * s2 + 0], S[kt][8 * s2 + 1]); w.y = pk_bf16(S[kt][8 * s2 + 2], S[kt][8 * s2 + 3]);
                        w.z = pk_bf16(S[kt][8 * s2 + 4], S[kt][8 * s2 + 5]); w.w = pk_bf16(S[kt][8 * s2 + 6], S[kt][8 * s2 + 7]); pf[kt][s2] = __builtin_bit_cast(bf16x8, w); }
                const unsigned blk = (lane >> 4) & 1, tq = (lane & 15) >> 2, tp = lane & 3;
#pragma unroll
                for (int kt = 0; kt < 2; ++kt)
#pragma unroll
                    for (int s2 = 0; s2 < 2; ++s2)
#pragma unroll
                        for (int dt = 0; dt < 4; ++dt) {
                            const unsigned row0 = 32 * kt + 16 * s2 + 4 * h2 + tq;
                            const s16x4 lo = lds_tr(lds + buf + VB0 + off_b(row0, 4 * dt + 2 * blk + (tp >> 1)) + 8 * (tp & 1));
                            const s16x4 hi = lds_tr(lds + buf + VB0 + off_b(row0 + 8, 4 * dt + 2 * blk + (tp >> 1)) + 8 * (tp & 1));
                            const bf16x8 vf = __builtin_shufflevector(lo, hi, 0, 1, 2, 3, 4, 5, 6, 7);
                            oacc[dt] = __builtin_amdgcn_mfma_f32_32x32x16_bf16(vf, pf[kt][s2], oacc[dt], 0, 0, 0);
                        }
            }
            if (it + 2 < ntiles) asm volatile("s_waitcnt vmcnt(4) lgkmcnt(0)" ::: "memory"); else asm volatile("s_waitcnt vmcnt(0) lgkmcnt(0)" ::: "memory");
            __builtin_amdgcn_s_barrier(); asm volatile("" ::: "memory");
            slot = (slot == 2) ? 0 : slot + 1;
        }
        l += __shfl_xor(l, 32);
        const float inv = 16.0f / l;
        unsigned char* orow = (unsigned char*)O + (tok0 + qpos) * 1024 + h * 128 + 4 * h2;
#pragma unroll
        for (int dt = 0; dt < 4; ++dt)
#pragma unroll
            for (int g4 = 0; g4 < 4; ++g4) { int w8 = 0; w8 = __builtin_amdgcn_cvt_pk_fp8_f32(oacc[dt][4 * g4] * inv, oacc[dt][4 * g4 + 1] * inv, w8, false); w8 = __builtin_amdgcn_cvt_pk_fp8_f32(oacc[dt][4 * g4 + 2] * inv, oacc[dt][4 * g4 + 3] * inv, w8, true);
                *(int*)(orow + 32 * dt + 8 * g4) = w8; }
        __syncthreads();
    }
    }
#undef ATT_STAGE
}


__device__ __forceinline__ void gla_chunk_phase(LAS unsigned char* lds, const bf16* P, const float* GKL_, const float* wup, const float* bgk, bf16* QEg, float* OB_, bf16* SLOC, float* DEC, const int G, const int bx, const int tid) {
    constexpr int QE_O = 0, KE_O = 16384, KD_O = 32768, V_O = 49152, SEG_O = 81920;
    const int lane = tid & 63, wave = __builtin_amdgcn_readfirstlane(tid >> 6), r32 = lane & 31, h2 = lane >> 5;
    const unsigned blk = (lane >> 4) & 1, tq = (lane & 15) >> 2, tp = lane & 3;
    LAS float* SEG = (LAS float*)(lds + SEG_O);
    const int vcu = (G % 8 == 0) ? (bx % 8) * (G / 8) + bx / 8 : bx;
    const int ustep = (G == 256) ? 32 : G, ubase = (G == 256) ? 128 * (bx & 7) + (bx >> 3) : vcu, uend = (G == 256) ? ubase + 128 : BATCH * 32 * CH;
    for (int u = ubase; u < uend; u += ustep) {
        const int hd = u & 3, c = (u >> 2) & 31, b = u >> 7;
        const size_t tok0 = (size_t)b * SEQ + c * 64;
#pragma unroll
        for (int jj = 0; jj < 4; ++jj) { const int pp = 4 * wave + jj, sub = pp >> 4; const unsigned row = 4 * (pp & 15) + (lane >> 4), cl = lane & 15, ch = cl ^ (((row & 3u) << 2) | ((row >> 2) & 3u));
            glds16(P + (tok0 + row) * 3072 + 1024 + hd * 256 + sub * 128 + ch * 8, LDS_ADDR(lds + V_O + sub * 16384 + 4 * (pp & 15) * 256)); }
        const int k2 = lane, seg = wave;
        f32x2 cum[8]; unsigned qp[8], kp[8];
        f32x2 wu[16]; const f32x2 bg = *(const f32x2*)(bgk + hd * 128 + 2 * k2);
#pragma unroll
        for (int t16 = 0; t16 < 16; ++t16) wu[t16] = *(const f32x2*)(wup + t16 * CKEY + hd * 128 + 2 * k2);
        LAS float* GK = (LAS float*)(lds + SEG_O + 4096);
        if (tid < 256) *(LAS f32x4*)(GK + 4 * tid) = *(const f32x4*)(GKL_ + tok0 * 16 + 4 * tid);
#pragma unroll
        for (int i = 0; i < 8; ++i) { const size_t row = tok0 + seg * 8 + i; qp[i] = *(const unsigned*)(P + row * 3072 + hd * 128 + 2 * k2); kp[i] = *(const unsigned*)(P + row * 3072 + 512 + hd * 128 + 2 * k2); }
        __syncthreads();
        { float c0 = 0.f, c1 = 0.f;
#pragma unroll
          for (int i = 0; i < 8; ++i) { f32x2 la = bg;
#pragma unroll
              for (int t4 = 0; t4 < 4; ++t4) { const f32x4 g4 = *(const LAS f32x4*)(GK + (seg * 8 + i) * 16 + 4 * t4);
#pragma unroll
                  for (int e = 0; e < 4; ++e) la += wu[4 * t4 + e] * g4[e]; }
              la.x = (fminf(la.x, 0.f) - __logf(1.0f + __expf(-fabsf(la.x)))) * (1.0f / 16.0f); la.y = (fminf(la.y, 0.f) - __logf(1.0f + __expf(-fabsf(la.y)))) * (1.0f / 16.0f);
              c0 += la.x; c1 += la.y; cum[i] = (f32x2){c0, c1}; }
          *(LAS f32x2*)(SEG + seg * 128 + 2 * k2) = (f32x2){c0, c1}; }
        __syncthreads();
        f32x2 pre = {0.f, 0.f}, tot = {0.f, 0.f};
#pragma unroll
        for (int s2 = 0; s2 < 8; ++s2) { const f32x2 v = *(const LAS f32x2*)(SEG + s2 * 128 + 2 * k2); tot += v; if (s2 < seg) pre += v; }
#pragma unroll
        for (int i = 0; i < 8; ++i) { const int row = seg * 8 + i; const f32x2 bb = pre + cum[i];
            const float q0 = __uint_as_float(qp[i] << 16) * 0.08838834764831845f, q1 = __uint_as_float(qp[i] & 0xffff0000u) * 0.08838834764831845f;
            const float k0 = __uint_as_float(kp[i] << 16), k1 = __uint_as_float(kp[i] & 0xffff0000u);
            const float e0 = __expf(bb.x), e1 = __expf(bb.y);
            const unsigned qe = pk_bf16(q0 * e0, q1 * e1), ke = pk_bf16(k0 * __expf(-bb.x), k1 * __expf(-bb.y)), kd = pk_bf16(k0 * __expf(tot.x - bb.x), k1 * __expf(tot.y - bb.y));
            const unsigned lo = off_b(row, k2 >> 2) + (k2 & 3) * 4;
            *(LAS unsigned*)(lds + QE_O + lo) = qe; *(LAS unsigned*)(lds + KE_O + lo) = ke; *(LAS unsigned*)(lds + KD_O + lo) = kd;
            *(unsigned*)(QEg + (tok0 + row) * CKEY + hd * 128 + 2 * k2) = qe; }
        if (seg == 0) *(f32x2*)(DEC + ((size_t)(b * CH + hd) * 32 + c) * 128 + 2 * k2) = (f32x2){__expf(tot.x), __expf(tot.y)};
        VM_WAIT(); __syncthreads();
        f32x16 X00, X01, X11;
#pragma unroll
        for (int i = 0; i < 16; ++i) { X00[i] = 0.f; X01[i] = 0.f; X11[i] = 0.f; }
#pragma unroll
        for (int ks = 0; ks < 8; ++ks) {
            const bf16x8 a0 = *(const LAS bf16x8*)(lds + KE_O + off_b(r32, 2 * ks + h2)), a1 = *(const LAS bf16x8*)(lds + KE_O + off_b(32 + r32, 2 * ks + h2));
            const bf16x8 b0 = *(const LAS bf16x8*)(lds + QE_O + off_b(r32, 2 * ks + h2)), b1 = *(const LAS bf16x8*)(lds + QE_O + off_b(32 + r32, 2 * ks + h2));
            X00 = __builtin_amdgcn_mfma_f32_32x32x16_bf16(a0, b0, X00, 0, 0, 0);
            X01 = __builtin_amdgcn_mfma_f32_32x32x16_bf16(a0, b1, X01, 0, 0, 0);
            X11 = __builtin_amdgcn_mfma_f32_32x32x16_bf16(a1, b1, X11, 0, 0, 0);
        }
#pragma unroll
        for (int i = 0; i < 16; ++i) { const int jl = (i & 3) + 8 * (i >> 2) + 4 * h2; if (jl > r32) { X00[i] = 0.f; X11[i] = 0.f; } }
        bf16x8 p00[2], p01[2], p11[2];
#pragma unroll
        for (int s2 = 0; s2 < 2; ++s2) { u32x4 w;
            w.x = pk_bf16(X00[8 * s2], X00[8 * s2 + 1]); w.y = pk_bf16(X00[8 * s2 + 2], X00[8 * s2 + 3]); w.z = pk_bf16(X00[8 * s2 + 4], X00[8 * s2 + 5]); w.w = pk_bf16(X00[8 * s2 + 6], X00[8 * s2 + 7]); p00[s2] = __builtin_bit_cast(bf16x8, w);
            w.x = pk_bf16(X01[8 * s2], X01[8 * s2 + 1]); w.y = pk_bf16(X01[8 * s2 + 2], X01[8 * s2 + 3]); w.z = pk_bf16(X01[8 * s2 + 4], X01[8 * s2 + 5]); w.w = pk_bf16(X01[8 * s2 + 6], X01[8 * s2 + 7]); p01[s2] = __builtin_bit_cast(bf16x8, w);
            w.x = pk_bf16(X11[8 * s2], X11[8 * s2 + 1]); w.y = pk_bf16(X11[8 * s2 + 2], X11[8 * s2 + 3]); w.z = pk_bf16(X11[8 * s2 + 4], X11[8 * s2 + 5]); w.w = pk_bf16(X11[8 * s2 + 6], X11[8 * s2 + 7]); p11[s2] = __builtin_bit_cast(bf16x8, w); }
        const int sv = wave >> 2, dt = wave & 3;
        LAS unsigned char* Vimg = lds + V_O + sv * 16384;
        f32x16 O0, O1;
#pragma unroll
        for (int i = 0; i < 16; ++i) { O0[i] = 0.f; O1[i] = 0.f; }
#pragma unroll
        for (int jt = 0; jt < 2; ++jt)
#pragma unroll
            for (int s2 = 0; s2 < 2; ++s2) {
                const unsigned row0 = 32 * jt + 16 * s2 + 4 * h2 + tq;
                const s16x4 lo = lds_tr(Vimg + off_b(row0, 4 * dt + 2 * blk + (tp >> 1)) + 8 * (tp & 1)), hi = lds_tr(Vimg + off_b(row0 + 8, 4 * dt + 2 * blk + (tp >> 1)) + 8 * (tp & 1));
                const bf16x8 vf = __builtin_shufflevector(lo, hi, 0, 1, 2, 3, 4, 5, 6, 7);
                if (jt == 0) { O0 = __builtin_amdgcn_mfma_f32_32x32x16_bf16(vf, p00[s2], O0, 0, 0, 0); O1 = __builtin_amdgcn_mfma_f32_32x32x16_bf16(vf, p01[s2], O1, 0, 0, 0); }
                else O1 = __builtin_amdgcn_mfma_f32_32x32x16_bf16(vf, p11[s2], O1, 0, 0, 0);
            }
        { bf16* ob = (bf16*)OB_ + (tok0 + r32) * 1024 + hd * 256 + 32 * wave + 4 * h2;
#pragma unroll
          for (int g4 = 0; g4 < 4; ++g4) { u32x2 w0, w1; w0.x = pk_bf16(O0[4 * g4], O0[4 * g4 + 1]); w0.y = pk_bf16(O0[4 * g4 + 2], O0[4 * g4 + 3]); w1.x = pk_bf16(O1[4 * g4], O1[4 * g4 + 1]); w1.y = pk_bf16(O1[4 * g4 + 2], O1[4 * g4 + 3]);
              *(u32x2*)(ob + 8 * g4) = w0; *(u32x2*)(ob + (size_t)32 * 1024 + 8 * g4) = w1; } }
        f32x16 Sa[4];
#pragma unroll
        for (int kt = 0; kt < 4; ++kt)
#pragma unroll
            for (int i = 0; i < 16; ++i) Sa[kt][i] = 0.f;
#pragma unroll
        for (int s4 = 0; s4 < 4; ++s4) {
            const unsigned rowb = 16 * s4 + 8 * h2 + tq;
            const s16x4 blo = lds_tr(Vimg + off_b(rowb, 4 * dt + 2 * blk + (tp >> 1)) + 8 * (tp & 1)), bhi = lds_tr(Vimg + off_b(rowb + 4, 4 * dt + 2 * blk + (tp >> 1)) + 8 * (tp & 1));
            const bf16x8 vb = __builtin_shufflevector(blo, bhi, 0, 1, 2, 3, 4, 5, 6, 7);
#pragma unroll
            for (int kt = 0; kt < 4; ++kt) {
                const s16x4 alo = lds_tr(lds + KD_O + off_b(rowb, 4 * kt + 2 * blk + (tp >> 1)) + 8 * (tp & 1)), ahi = lds_tr(lds + KD_O + off_b(rowb + 4, 4 * kt + 2 * blk + (tp >> 1)) + 8 * (tp & 1));
                const bf16x8 ka = __builtin_shufflevector(alo, ahi, 0, 1, 2, 3, 4, 5, 6, 7);
                Sa[kt] = __builtin_amdgcn_mfma_f32_32x32x16_bf16(ka, vb, Sa[kt], 0, 0, 0);
            }
        }
        { unsigned char* sp = (unsigned char*)SLOC + ((size_t)(b * CH + hd) * 32 + c) * (CDV * CDK) + (size_t)(32 * wave + r32) * CDK + 4 * h2;
#pragma unroll
          for (int kt = 0; kt < 4; ++kt)
#pragma unroll
              for (int g4 = 0; g4 < 4; ++g4) { int w8 = 0; w8 = __builtin_amdgcn_cvt_pk_fp8_f32(Sa[kt][4 * g4], Sa[kt][4 * g4 + 1], w8, false); w8 = __builtin_amdgcn_cvt_pk_fp8_f32(Sa[kt][4 * g4 + 2], Sa[kt][4 * g4 + 3], w8, true); *(int*)(sp + 32 * kt + 8 * g4) = w8; } }
        __syncthreads();
    }
}
struct ScanSet { bf16x8 qb[2]; u32x2 sl; u32x2 ob; };
__device__ __forceinline__ void gla_scan_phase(LAS unsigned char* lds, const bf16* QEg, float* OB_, const bf16* SLOC, const float* DEC, const int G, const int bx, const int tid) {
    const int lane = tid & 63, wave = __builtin_amdgcn_readfirstlane(tid >> 6), r32 = lane & 31, h2 = lane >> 5, tl = lane >> 3, vq = lane & 7;
    constexpr int DL_O = 65536;
    LAS float* DL = (LAS float*)(lds + DL_O);
    const int vcu = (G % 8 == 0) ? (bx % 8) * (G / 8) + bx / 8 : bx;
    for (int u = vcu; u < BATCH * CH * 8; u += G) {
        const int vs = u & 7, hd = (u >> 3) & 3, b = u >> 5;
        const size_t bhc = (size_t)(b * CH + hd) * 32;
        for (int i = tid; i < 32 * 128 / 4; i += NTHR) ((LAS f32x4*)DL)[i] = ((const f32x4*)(DEC + bhc * 128))[i];
        float st[8];
#pragma unroll
        for (int j2 = 0; j2 < 8; ++j2) st[j2] = 0.f;
        const bf16* qbase = QEg + ((size_t)b * SEQ + r32) * CKEY + hd * 128 + 16 * wave + 8 * h2;
        const unsigned char* sbase = (const unsigned char*)SLOC + bhc * (CDV * CDK) + (size_t)(32 * vs + r32) * CDK + 16 * wave + 8 * h2;
        bf16* obase = (bf16*)OB_ + ((size_t)b * SEQ + 8 * wave + tl) * 1024 + hd * 256 + 32 * vs + 4 * vq;
        const unsigned pw = (unsigned)(wave * 8192 + r32 * 128), psw = (unsigned)(r32 & 7);
        const int ro = (8 * wave + tl) & 31;
        const unsigned pr = (unsigned)((wave >> 2) * 4096 + ro * 128 + ((vq ^ (ro & 7)) * 16));
        const LAS float* dlp = DL + 16 * wave + 8 * h2;
#define SCAN_LOAD(S_, cc) do { S_.qb[0] = *(const bf16x8*)(qbase + (size_t)(cc) * 64 * CKEY); S_.qb[1] = *(const bf16x8*)(qbase + (size_t)(cc) * 64 * CKEY + 32 * CKEY); \
            S_.sl = *(const u32x2*)(sbase + (size_t)(cc) * (CDV * CDK)); S_.ob = *(const u32x2*)(obase + (size_t)(cc) * 64 * 1024); } while (0)
#define SCAN_STEP(S_, cc) do { \
            if ((cc) > 0) { u32x4 aw; aw.x = pk_bf16(st[0], st[1]); aw.y = pk_bf16(st[2], st[3]); aw.z = pk_bf16(st[4], st[5]); aw.w = pk_bf16(st[6], st[7]); const bf16x8 av = __builtin_bit_cast(bf16x8, aw); \
                f32x16 c0, c1; _Pragma("unroll") for (int i = 0; i < 16; ++i) { c0[i] = 0.f; c1[i] = 0.f; } \
                c0 = __builtin_amdgcn_mfma_f32_32x32x16_bf16(av, S_.qb[0], c0, 0, 0, 0); c1 = __builtin_amdgcn_mfma_f32_32x32x16_bf16(av, S_.qb[1], c1, 0, 0, 0); \
                _Pragma("unroll") for (int g = 0; g < 4; ++g) { const unsigned so = pw + (((unsigned)(2 * g + h2) ^ psw) << 4); \
                    *(LAS f32x4*)(lds + so) = (f32x4){c0[4 * g], c0[4 * g + 1], c0[4 * g + 2], c0[4 * g + 3]}; *(LAS f32x4*)(lds + so + 4096) = (f32x4){c1[4 * g], c1[4 * g + 1], c1[4 * g + 2], c1[4 * g + 3]}; } } \
            { const f32x2 p0 = __builtin_amdgcn_cvt_pk_f32_fp8((int)S_.sl.x, false), p1 = __builtin_amdgcn_cvt_pk_f32_fp8((int)S_.sl.x, true), p2 = __builtin_amdgcn_cvt_pk_f32_fp8((int)S_.sl.y, false), p3 = __builtin_amdgcn_cvt_pk_f32_fp8((int)S_.sl.y, true); \
              const f32x4 d0 = *(const LAS f32x4*)(dlp + (cc) * 128), d1 = *(const LAS f32x4*)(dlp + (cc) * 128 + 4); \
              st[0] = d0[0] * st[0] + p0.x; st[1] = d0[1] * st[1] + p0.y; st[2] = d0[2] * st[2] + p1.x; st[3] = d0[3] * st[3] + p1.y; \
              st[4] = d1[0] * st[4] + p2.x; st[5] = d1[1] * st[5] + p2.y; st[6] = d1[2] * st[6] + p3.x; st[7] = d1[3] * st[7] + p3.y; } \
            if ((cc) > 0) { LDS_WAIT(); __builtin_amdgcn_s_barrier(); asm volatile("" ::: "memory"); \
                f32x4 sm = *(const LAS f32x4*)(lds + pr); \
                _Pragma("unroll") for (int s2 = 1; s2 < 8; ++s2) sm += *(const LAS f32x4*)(lds + pr + s2 * 8192); \
                u32x2 ow; ow.x = pk_bf16(__uint_as_float(S_.ob.x << 16) + sm[0], __uint_as_float(S_.ob.x & 0xffff0000u) + sm[1]); ow.y = pk_bf16(__uint_as_float(S_.ob.y << 16) + sm[2], __uint_as_float(S_.ob.y & 0xffff0000u) + sm[3]); \
                *(u32x2*)(obase + (size_t)(cc) * 64 * 1024) = ow; \
                LDS_WAIT(); __builtin_amdgcn_s_barrier(); asm volatile("" ::: "memory"); } } while (0)
        ScanSet A, B, C, E;
        SCAN_LOAD(A, 0); SCAN_LOAD(B, 1); SCAN_LOAD(C, 2); SCAN_LOAD(E, 3);
        __syncthreads();
#pragma unroll 1
        for (int c = 0; c < 28; c += 4) {
            SCAN_STEP(A, c); SCAN_LOAD(A, c + 4);
            SCAN_STEP(B, c + 1); SCAN_LOAD(B, c + 5);
            SCAN_STEP(C, c + 2); SCAN_LOAD(C, c + 6);
            SCAN_STEP(E, c + 3); SCAN_LOAD(E, c + 7);
        }
        SCAN_STEP(A, 28); SCAN_STEP(B, 29); SCAN_STEP(C, 30); SCAN_STEP(E, 31);
#undef SCAN_LOAD
#undef SCAN_STEP
        __syncthreads();
    }
}

__device__ __forceinline__ void gmlp_mix_phase(LAS unsigned char* lds, const bf16* Z, const float* ST, const float* lng, const float* lnb, const float* wsp, const float* bsp, bf16* Y, const int G, const int bx, const int tid) {
    constexpr int VL_O = 0, W_O = 65536, RS_O = 98304;
    const int lane = tid & 63, wave = __builtin_amdgcn_readfirstlane(tid >> 6), r32 = lane & 31, h2 = lane >> 5;
    const unsigned blk = (lane >> 4) & 1, tq = (lane & 15) >> 2, tp = lane & 3;
    LAS f32x2* RS = (LAS f32x2*)(lds + RS_O);
    const int vcu = (G % 8 == 0) ? (bx % 8) * (G / 8) + bx / 8 : bx;
    int gprev = -1;
    u32x4 zv[8];
#define GM_ZLOAD(u_) do { const int g_ = (u_) & 7; const size_t t0_ = (size_t)((u_) >> 7) * SEQ + (((u_) >> 3) & 15) * 128; _Pragma("unroll") for (int i = 0; i < 8; ++i) zv[i] = *(const u32x4*)(Z + (t0_ + (tid >> 5) + 16 * i) * 4096 + 2048 + g_ * 256 + (tid & 31) * 8); } while (0)
    const int ustep = (G == 256) ? 32 : G, ubase = (G == 256) ? 128 * (bx & 7) + (bx >> 3) : vcu, uend = (G == 256) ? ubase + 128 : BATCH * 16 * BG;
    if (ubase < uend) GM_ZLOAD(ubase);
    for (int u = ubase; u < uend; u += ustep) {
        const int g = u & 7, cch = (u >> 3) & 15, b = u >> 7;
        const size_t tok0 = (size_t)b * SEQ + cch * 128;
        if (tid < 128) { float s = 0.f, q = 0.f; const f32x4* sp = (const f32x4*)(ST + (tok0 + tid) * 64);
#pragma unroll
            for (int i = 0; i < 16; ++i) { const f32x4 v = sp[i]; s += v[0] + v[2]; q += v[1] + v[3]; }
            const float mean = s * (1.0f / 2048.0f), var = fmaxf(q * (1.0f / 2048.0f) - mean * mean, 0.f); RS[tid] = (f32x2){mean, 1.0f / sqrtf(var + LN_EPS)}; }
        if (g != gprev) {
#pragma unroll
        for (int i = 0; i < 4; ++i) { const int id = tid + NTHR * i, t = id >> 4, ch = id & 15; const float* wp = wsp + ((size_t)g * 128 + t) * 128 + ch * 8; const f32x4 w0 = *(const f32x4*)wp, w1 = *(const f32x4*)(wp + 4);
            float w[8] = {w0[0], w0[1], w0[2], w0[3], w1[0], w1[1], w1[2], w1[3]};
#pragma unroll
            for (int e = 0; e < 8; ++e) if (ch * 8 + e > t) w[e] = 0.f;
            u32x4 o; o.x = pk_bf16(w[0], w[1]); o.y = pk_bf16(w[2], w[3]); o.z = pk_bf16(w[4], w[5]); o.w = pk_bf16(w[6], w[7]);
            *(LAS u32x4*)(lds + W_O + off_b(t, ch)) = o; }
        gprev = g; }
        __syncthreads();
        { const int ch32 = tid & 31; const f32x4 g0 = *(const f32x4*)(lng + g * 256 + ch32 * 8), g1 = *(const f32x4*)(lng + g * 256 + ch32 * 8 + 4), b0 = *(const f32x4*)(lnb + g * 256 + ch32 * 8), b1 = *(const f32x4*)(lnb + g * 256 + ch32 * 8 + 4);
#pragma unroll
          for (int i = 0; i < 8; ++i) { const int row = (tid >> 5) + 16 * i; const u32x4 zw = zv[i]; const f32x2 rs = RS[row];
              const float z[8] = {__uint_as_float(zw.x << 16), __uint_as_float(zw.x & 0xffff0000u), __uint_as_float(zw.y << 16), __uint_as_float(zw.y & 0xffff0000u),
                                  __uint_as_float(zw.z << 16), __uint_as_float(zw.z & 0xffff0000u), __uint_as_float(zw.w << 16), __uint_as_float(zw.w & 0xffff0000u)};
              u32x4 o; o.x = pk_bf16((z[0] - rs.x) * rs.y * g0[0] + b0[0], (z[1] - rs.x) * rs.y * g0[1] + b0[1]); o.y = pk_bf16((z[2] - rs.x) * rs.y * g0[2] + b0[2], (z[3] - rs.x) * rs.y * g0[3] + b0[3]);
              o.z = pk_bf16((z[4] - rs.x) * rs.y * g1[0] + b1[0], (z[5] - rs.x) * rs.y * g1[1] + b1[1]); o.w = pk_bf16((z[6] - rs.x) * rs.y * g1[2] + b1[2], (z[7] - rs.x) * rs.y * g1[3] + b1[3]);
              *(LAS u32x4*)(lds + VL_O + (ch32 >> 4) * 32768 + off_b(row, ch32 & 15)) = o; } }
        __syncthreads();
        if (u + ustep < uend) GM_ZLOAD(u + ustep);
        u32x2 uvr[4][4]; float bsr[4];
#pragma unroll
        for (int tt = 0; tt < 4; ++tt) { const int t = 32 * tt + r32; bsr[tt] = bsp[g * 128 + t]; const bf16* up = Z + (tok0 + t) * 4096 + g * 256 + 32 * wave + 4 * h2;
#pragma unroll
            for (int g4 = 0; g4 < 4; ++g4) uvr[tt][g4] = *(const u32x2*)(up + 8 * g4); }
        __builtin_amdgcn_sched_barrier(0);
        f32x16 acc[4];
#pragma unroll
        for (int tt = 0; tt < 4; ++tt)
#pragma unroll
            for (int i = 0; i < 16; ++i) acc[tt][i] = 0.f;
        LAS unsigned char* Vimg = lds + VL_O + (wave >> 2) * 32768; const int dt = wave & 3;
#pragma unroll
        for (int ks = 0; ks < 8; ++ks) {
            const unsigned rowb = 16 * ks + 8 * h2 + tq;
            const s16x4 alo = lds_tr(Vimg + off_b(rowb, 4 * dt + 2 * blk + (tp >> 1)) + 8 * (tp & 1)), ahi = lds_tr(Vimg + off_b(rowb + 4, 4 * dt + 2 * blk + (tp >> 1)) + 8 * (tp & 1));
            const bf16x8 va = __builtin_shufflevector(alo, ahi, 0, 1, 2, 3, 4, 5, 6, 7);
#pragma unroll
            for (int tt = ks >> 1; tt < 4; ++tt) { const bf16x8 wb = *(const LAS bf16x8*)(lds + W_O + off_b(32 * tt + r32, 2 * ks + h2)); acc[tt] = __builtin_amdgcn_mfma_f32_32x32x16_bf16(va, wb, acc[tt], 0, 0, 0); }
        }
#pragma unroll
        for (int tt = 0; tt < 4; ++tt) { const int t = 32 * tt + r32; const float bs = bsr[tt];
            unsigned char* yp = (unsigned char*)Y + (tok0 + t) * 2048 + g * 256 + 32 * wave + 4 * h2;
#pragma unroll
            for (int g4 = 0; g4 < 4; ++g4) { const u32x2 uv = uvr[tt][g4];
                int w8 = 0; w8 = __builtin_amdgcn_cvt_pk_fp8_f32(__uint_as_float(uv.x << 16) * (acc[tt][4 * g4] + bs), __uint_as_float(uv.x & 0xffff0000u) * (acc[tt][4 * g4 + 1] + bs), w8, false);
                w8 = __builtin_amdgcn_cvt_pk_fp8_f32(__uint_as_float(uv.y << 16) * (acc[tt][4 * g4 + 2] + bs), __uint_as_float(uv.y & 0xffff0000u) * (acc[tt][4 * g4 + 3] + bs), w8, true);
                *(int*)(yp + 8 * g4) = w8; } }
        __syncthreads();
    }
#undef GM_ZLOAD
}

template <int layer>
__device__ __forceinline__ void layer_body(const int lo, const int hi, const int G, const int bx, LAS unsigned char* lds, const XcdBarrier bar) {
        constexpr int mixer = layer % 3, j = layer / 3;
        const int vb = (G % 8 == 0) ? (bx % 8) * (G / 8) + bx / 8 : bx;
        int pid = 1 + (layer > 0 ? 7 : 0) + (layer > 1 ? 7 : 0) + (layer > 2 ? 9 : 0);
        if constexpr (mixer == 0) {
            PH_BEGIN
                pg8::Gemm g{HB, (const bf16*)(WSP + WS_AIN) + (size_t)j * 3072 * D, 2 * D}; pg8::StaticOrder S; S.init(T / 256, 12, G, bx);
                pg8::EpiBf16 E{BIG1, 3072, KMEAN};
                pg8::gemm_phase<pg8::EpiBf16, pg8::StaticOrder, true, false>(lds, g, S, E);
            PH_END
            PH_BEGIN
                attn_phase(lds, BIG1, BIG2, IN_(1), KMEAN, G, bx, tid);
            PH_END
            PH_BEGIN
                pg8::Gemm g{BIG2, (const bf16*)((unsigned char*)(WSP + WS_AOUT) + (size_t)j * D * D), D, 0x74747474}; pg8::StaticOrder S; S.init(T / 256, 4, G, bx);
                pg8::EpiResid E{HB, UB, ALPHA};
                pg8::gemm_phase<pg8::EpiResid, pg8::StaticOrder, true, false, true>(lds, g, S, E);
            PH_END
        } else if constexpr (mixer == 1) {
            PH_BEGIN
                pg8::Gemm g{(const bf16*)HB8, (const bf16*)(WSP + WS_BIN), D, FP8_GU_SCALE}; pg8::StaticOrder S; S.init(T / 256, 16, G, bx);
                pg8::EpiGelu E{BIG1, STATS};
                pg8::gemm_phase<pg8::EpiGelu, pg8::StaticOrder, true, false, true>(lds, g, S, E);
            PH_END
            PH_BEGIN
                gmlp_mix_phase(lds, BIG1, STATS, IN_(5), IN_(6), IN_(7), IN_(8), BIG2, G, bx, tid);
            PH_END
            PH_BEGIN
                pg8::Gemm g{BIG2, (const bf16*)(WSP + WS_BOUT), BW, 0x78787878}; pg8::StaticOrder S; S.init(T / 256, 4, G, bx);
                pg8::EpiResid E{HB, UB, ALPHA};
                pg8::gemm_phase<pg8::EpiResid, pg8::StaticOrder, true, false, true>(lds, g, S, E);
            PH_END
        } else {
            PH_BEGIN
                pg8::Gemm g{(const bf16*)HB8, (const bf16*)(WSP + WS_CIN), D, FP8_GU_SCALE}; pg8::StaticOrder S; S.init(T / 256, 12, G, bx);
                pg8::EpiBf16 E{BIG1, 3072};
                pg8::gemm_phase<pg8::EpiBf16, pg8::StaticOrder, true, false, true>(lds, g, S, E);
            PH_END
            PH_BEGIN
                gla_chunk_phase(lds, BIG1, GKL, IN_(11), IN_(12), GQE, OB, (bf16*)ACT, GDEC, G, bx, tid);
            PH_END
            PH_BEGIN
                gla_scan_phase(lds, GQE, OB, (const bf16*)ACT, GDEC, G, bx, tid);
            PH_END
            PH_BEGIN
                const float* ng = IN_(13);
                for (int ri = 0; ri < 8; ++ri) { const int row = (vb * NWAVES + wave) * 8 + ri;
#pragma unroll
                    for (int hd = 0; hd < 4; ++hd) { const u32x2 ov = *(const u32x2*)((const bf16*)OB + (size_t)row * 1024 + hd * 256 + 4 * lane);
                        const f32x4 o = {__uint_as_float(ov.x << 16), __uint_as_float(ov.x & 0xffff0000u), __uint_as_float(ov.y << 16), __uint_as_float(ov.y & 0xffff0000u)};
                        const float ss = wave_sum(o[0] * o[0] + o[1] * o[1] + o[2] * o[2] + o[3] * o[3]); const float r = 1.0f / sqrtf(ss * (1.0f / 256.0f) + LN_EPS);
                        const u32x2 gv = *(const u32x2*)(BIG1 + (size_t)row * 3072 + 2048 + hd * 256 + 4 * lane); const f32x4 gn = *(const f32x4*)(ng + 4 * lane);
                        const float gg[4] = {__uint_as_float(gv.x << 16), __uint_as_float(gv.x & 0xffff0000u), __uint_as_float(gv.y << 16), __uint_as_float(gv.y & 0xffff0000u)}; float y[4];
#pragma unroll
                        for (int i = 0; i < 4; ++i) y[i] = o[i] * (4.0f * r) * gn[i] * (gg[i] / (1.0f + __expf(-gg[i])));
                        int w8 = 0; w8 = __builtin_amdgcn_cvt_pk_fp8_f32(y[0], y[1], w8, false); w8 = __builtin_amdgcn_cvt_pk_fp8_f32(y[2], y[3], w8, true); *(int*)((unsigned char*)BIG2 + (size_t)row * 1024 + hd * 256 + 4 * lane) = w8; }
                }
            PH_END
            PH_BEGIN
                pg8::Gemm g{BIG2, (const bf16*)(WSP + WS_COUT), D, 0x76767676}; pg8::StaticOrder S; S.init(T / 256, 4, G, bx);
                pg8::EpiResid E{HB, UB, ALPHA};
                pg8::gemm_phase<pg8::EpiResid, pg8::StaticOrder, true, false, true>(lds, g, S, E);
            PH_END
        }

        LAS int* lcnt = (LAS int*)(lds + MISC_OFF + 256);
        LAS int* tstart = (LAS int*)(lds + MISC_OFF + 512);
        LAS int* tile_e = (LAS int*)(lds + MISC_OFF + 1024);
        LAS int* idxtab = (LAS int*)(lds + IDX_OFF);
        PH_BEGIN
            const float* lg = IN_(15) + (size_t)(layer * 2 + 0) * D; const float* lb = IN_(16) + (size_t)(layer * 2 + 0) * D;
            const bf16* wrh = WRH + (size_t)layer * NE * D; const bf16* wrl = WRL + (size_t)layer * NE * D; const float* brt = IN_(18) + layer * NE;
            LAS int* gbase = (LAS int*)(lds + IDX_OFF);
            LAS float* lgt = (LAS float*)(lds + IDX_OFF + 256) + wave * 256;
            LAS float* top = (LAS float*)(lds + IDX_OFF + 8448) + wave * 8;
            LAS float* rec = (LAS float*)(lds + IDX_OFF + 8704);
            if (tid < 32) lcnt[tid] = 0;
            __syncthreads();
            f32x4 y[8][4];
            {   f32x4 gv[4], bv[4];
#pragma unroll
                for (int jj = 0; jj < 4; ++jj) { gv[jj] = *(const f32x4*)(lg + 4 * lane + 256 * jj); bv[jj] = *(const f32x4*)(lb + 4 * lane + 256 * jj); }
                u32x2 raw[8][4];
#pragma unroll
                for (int i = 0; i < 8; ++i)
#pragma unroll
                    for (int jj = 0; jj < 4; ++jj) raw[i][jj] = *(const u32x2*)(UB + (size_t)(vb * 64 + wave * 8 + i) * D + 4 * lane + 256 * jj);
#pragma unroll
                for (int i = 0; i < 8; ++i) { const int row = vb * 64 + wave * 8 + i; float s = 0.f;
#pragma unroll
                    for (int jj = 0; jj < 4; ++jj) { const u32x2 uv = raw[i][jj];
                        y[i][jj] = (f32x4){__uint_as_float(uv.x << 16), __uint_as_float(uv.x & 0xffff0000u), __uint_as_float(uv.y << 16), __uint_as_float(uv.y & 0xffff0000u)};
                        s += (y[i][jj][0] + y[i][jj][1]) + (y[i][jj][2] + y[i][jj][3]); }
                    const float mean = wave_sum(s) * (1.0f / D); float s2 = 0.f;
#pragma unroll
                    for (int jj = 0; jj < 4; ++jj) { y[i][jj] = y[i][jj] - mean; s2 += (y[i][jj][0] * y[i][jj][0] + y[i][jj][1] * y[i][jj][1]) + (y[i][jj][2] * y[i][jj][2] + y[i][jj][3] * y[i][jj][3]); }
                    const float rstd = 1.0f / sqrtf(wave_sum(s2) * (1.0f / D) + LN_EPS);
#pragma unroll
                    for (int jj = 0; jj < 4; ++jj) { y[i][jj] = y[i][jj] * rstd * gv[jj] + bv[jj];
                        u32x2 w; w.x = cvt_pk_bf16(y[i][jj][0], y[i][jj][1]); w.y = cvt_pk_bf16(y[i][jj][2], y[i][jj][3]); *(u32x2*)(HB + (size_t)row * D + 4 * lane + 256 * jj) = w;
                        int w8 = 0; w8 = __builtin_amdgcn_cvt_pk_fp8_f32(y[i][jj][0], y[i][jj][1], w8, false); w8 = __builtin_amdgcn_cvt_pk_fp8_f32(y[i][jj][2], y[i][jj][3], w8, true); *(int*)(HB8 + (size_t)row * D + 4 * lane + 256 * jj) = w8; } }
            }
            {
                const int rt = wave & 1, kq = wave >> 1, r32 = lane & 31, h2 = lane >> 5;
                f32x16 lacc;
#pragma unroll
                for (int a = 0; a < 16; ++a) lacc[a] = 0.f;
#pragma unroll
                for (int jj = 0; jj < 4; ++jj) {
                    bf16x8 bh[4], bl[4];
#pragma unroll
                    for (int k4 = 0; k4 < 4; ++k4) { const size_t wo = (size_t)r32 * D + 256 * jj + 16 * (4 * kq + k4) + 8 * h2; bh[k4] = *(const bf16x8*)(wrh + wo); bl[k4] = *(const bf16x8*)(wrl + wo); }
#pragma unroll
                    for (int i = 0; i < 8; ++i) { const int row = wave * 8 + i; const f32x4 yv = y[i][jj];
                        const unsigned h0 = cvt_pk_bf16(yv[0], yv[1]), h1 = cvt_pk_bf16(yv[2], yv[3]);
                        const unsigned l0 = cvt_pk_bf16(yv[0] - __uint_as_float(h0 << 16), yv[1] - __uint_as_float(h0 & 0xffff0000u)), l1 = cvt_pk_bf16(yv[2] - __uint_as_float(h1 << 16), yv[3] - __uint_as_float(h1 & 0xffff0000u));
                        const unsigned ad = (lane >> 5) * 16384 + off_b(row, (lane & 31) >> 1) + 8 * (lane & 1);
                        *(LAS u32x2*)(lds + ad) = (u32x2){h0, h1}; *(LAS u32x2*)(lds + 32768 + ad) = (u32x2){l0, l1}; }
                    LDS_WAIT(); __builtin_amdgcn_s_barrier(); asm volatile("" ::: "memory");
#pragma unroll
                    for (int k4 = 0; k4 < 4; ++k4) { const int ks = 4 * kq + k4; const unsigned ad = (ks >> 3) * 16384 + off_b(32 * rt + r32, 2 * (ks & 7) + h2);
                        const bf16x8 ah = *(const LAS bf16x8*)(lds + ad), al = *(const LAS bf16x8*)(lds + 32768 + ad);
                        lacc = __builtin_amdgcn_mfma_f32_32x32x16_bf16(ah, bh[k4], lacc, 0, 0, 0);
                        lacc = __builtin_amdgcn_mfma_f32_32x32x16_bf16(ah, bl[k4], lacc, 0, 0, 0);
                        lacc = __builtin_amdgcn_mfma_f32_32x32x16_bf16(al, bh[k4], lacc, 0, 0, 0); }
                    LDS_WAIT(); __builtin_amdgcn_s_barrier(); asm volatile("" ::: "memory");
                }
                LAS float* red = (LAS float*)(lds + 65536);
#pragma unroll
                for (int a = 0; a < 16; ++a) red[(kq * 64 + 32 * rt + (a & 3) + 8 * (a >> 2) + 4 * h2) * 32 + r32] = lacc[a];
                LDS_WAIT(); __builtin_amdgcn_s_barrier(); asm volatile("" ::: "memory");
                if (lane < 32) {
#pragma unroll
                    for (int i = 0; i < 8; ++i) { const int row = wave * 8 + i; lgt[i * 32 + lane] = (red[(0 * 64 + row) * 32 + lane] + red[(1 * 64 + row) * 32 + lane]) + (red[(2 * 64 + row) * 32 + lane] + red[(3 * 64 + row) * 32 + lane]) + brt[lane]; }
                }
            }
            LDS_WAIT();
            {
                const int l31 = lane & 31, hh = lane >> 5; LAS float* tp2 = (LAS float*)(lds + IDX_OFF + 11776) + wave * 16 + hh * 8;
                for (int i = 0; i < 4; ++i) {
                    const int ri = i + 4 * hh, rl = wave * 8 + ri;
                    const float mylog = lgt[ri * 32 + l31];
                    int rank = 0;
                    for (int e = 0; e < NE; ++e) { const float o = lgt[ri * 32 + e]; rank += (o > mylog || (o == mylog && e < l31)) ? 1 : 0; }
                    if (rank < 4) { tp2[rank * 2] = mylog; tp2[rank * 2 + 1] = __int_as_float(l31); }
                    LDS_WAIT();
                    if (l31 < 4) { const float m0 = tp2[0]; const float e0 = __expf(tp2[0] - m0), e1 = __expf(tp2[2] - m0), e2 = __expf(tp2[4] - m0), e3 = __expf(tp2[6] - m0);
                        const float mine = __expf(tp2[l31 * 2] - m0) / ((e0 + e1) + (e2 + e3)); const int ex = __float_as_int(tp2[l31 * 2 + 1]);
                        const int lp = atomicAdd((int*)(lcnt + ex), 1);
                        rec[(rl * 4 + l31) * 3 + 0] = __int_as_float(ex); rec[(rl * 4 + l31) * 3 + 1] = __int_as_float(lp); rec[(rl * 4 + l31) * 3 + 2] = mine; }
                    LDS_WAIT();
                }
            }
            __syncthreads();
            if (tid < 32) gbase[tid] = (int)__hip_atomic_fetch_add((unsigned*)(cursor + tid), (unsigned)lcnt[tid], __ATOMIC_RELAXED, __HIP_MEMORY_SCOPE_AGENT);
            __syncthreads();
            if (tid < 256) { const int rl = tid >> 2, k = tid & 3, row = vb * 64 + rl;
                const int ex = __float_as_int(rec[tid * 3 + 0]), lp = __float_as_int(rec[tid * 3 + 1]); const float gt = rec[tid * 3 + 2];
                const int pos = gbase[ex] + lp;
                TOK[(size_t)ex * T + pos] = row; SELE[row * 4 + k] = ex; SELP[row * 4 + k] = pos; SELG[row * 4 + k] = gt; }
            if (hi - lo > 1) wq_drain(ap, layer, lane);
            else { for (int it_ = bx * NWAVES + wave; it_ < CONV_TOTAL; it_ += G * NWAVES) conv_unified(MOE_GU(layer), MOE_DN(layer), MOE_GUT(layer), MOE_DNT(layer), it_, it_ + 1, lane); }
            __syncthreads();
        PH_END
#define BUILD_TILES() do { if (tid < NE) lcnt[tid] = (int)__hip_atomic_load((unsigned*)(cursor + tid), __ATOMIC_RELAXED, __HIP_MEMORY_SCOPE_AGENT); __syncthreads(); \
            if (tid == 0) { int acc_ = 0; for (int e = 0; e < NE; ++e) { tstart[e] = acc_; acc_ += (lcnt[e] + 255) >> 8; } tstart[NE] = acc_; } __syncthreads(); \
            if (tid < NE) { const int t0_ = tstart[tid], t1_ = tstart[tid + 1]; for (int t_ = t0_; t_ < t1_; ++t_) tile_e[t_] = tid; } __syncthreads(); } while (0)
        PH_BEGIN
            BUILD_TILES();
            const int ntiles = tstart[NE];
            pg8::MoeOrder S; S.so.init(ntiles, 8, G, bx); S.tile_e = tile_e; S.idx = idxtab;
            { pg8::Unit u; for (int i = 0; i < MAXU && S.next(i, u); ++i) { if (tid < 256) { const int rr = (u.pm - tstart[u.e]) * 256 + tid; idxtab[i * 256 + tid] = (rr < lcnt[u.e]) ? TOK[(size_t)u.e * T + rr] : 0; } } }
            __syncthreads();
            pg8::Gemm g{(const bf16*)HB8, (const bf16*)((unsigned char*)(WSP + WS_GU) + (size_t)layer * NE * 2048 * D), D, FP8_GU_SCALE};
            pg8::EpiSwiglu E{(unsigned char*)ACT, IN_(20) + (size_t)layer * NE * 2048};
            pg8::gemm_phase<pg8::EpiSwiglu, pg8::MoeOrder, true, true, true>(lds, g, S, E);
        PH_END
        PH_BEGIN
            if (lo == pid) BUILD_TILES();
            const int ntiles = tstart[NE];
            pg8::MoeOrder S; S.so.init(ntiles, 4, G, bx); S.tile_e = tile_e; S.idx = idxtab;
            pg8::Gemm g{ACT, (const bf16*)((unsigned char*)(WSP + WS_DN) + (size_t)layer * NE * D * D), D, FP8_DN_SCALE};
            pg8::EpiYs8 E{(unsigned char*)YS};
            pg8::gemm_phase<pg8::EpiYs8, pg8::MoeOrder, true, false, true>(lds, g, S, E);
        PH_END
        PH_BEGIN
            if (lo == pid) BUILD_TILES();
            const float* lg = IN_(15) + (size_t)(layer * 2 + 1) * D; const float* lb = IN_(16) + (size_t)(layer * 2 + 1) * D;
            const float* bdn = IN_(22) + (size_t)layer * NE * D;
            LAS float* lgs = (LAS float*)(lds + IDX_OFF); LAS float* lbs = lgs + D;
            if (tid < 256) { ((LAS f32x4*)lgs)[tid] = ((const f32x4*)lg)[tid]; ((LAS f32x4*)lbs)[tid] = ((const f32x4*)lb)[tid]; }
#pragma unroll 4
            for (int i = tid; i < NE * D / 4; i += NTHR) { const f32x4 bv_ = ((const f32x4*)bdn)[i]; u32x2 w_; w_.x = cvt_pk_bf16(bv_[0], bv_[1]); w_.y = cvt_pk_bf16(bv_[2], bv_[3]); ((LAS u32x2*)(lds + 65536))[i] = w_; }
            if constexpr ((layer + 1) % 3 == 2) { for (int i = tid; i < 16 * D / 4; i += NTHR) ((LAS f32x4*)lds)[i] = ((const f32x4*)W16T)[i]; }
            __syncthreads();
#pragma unroll 1
            for (int rp = 0; rp < 4; ++rp) {
                const int rowa = (vb * NWAVES + wave) * 8 + 2 * rp;
                int lz = lane; asm volatile("" : "+v"(lz));
                f32x4 v[2][4];
                int ex[2][4], pos[2][4]; float gt[2][4];
#pragma unroll
                for (int q = 0; q < 2; ++q)
#pragma unroll
                    for (int k = 0; k < 4; ++k) { ex[q][k] = __builtin_amdgcn_readfirstlane(SELE[(rowa + q) * 4 + k]); pos[q][k] = __builtin_amdgcn_readfirstlane(SELP[(rowa + q) * 4 + k]);
                        gt[q][k] = __int_as_float(__builtin_amdgcn_readfirstlane(__float_as_int(SELG[(rowa + q) * 4 + k]))); }
#pragma unroll
                for (int q = 0; q < 2; ++q)
#pragma unroll
                    for (int jj = 0; jj < 4; ++jj) { const u32x2 hv = *(const u32x2*)(HB + (size_t)(rowa + q) * D + 4 * lz + 256 * jj);
                        v[q][jj] = (f32x4){__uint_as_float(hv.x << 16), __uint_as_float(hv.x & 0xffff0000u), __uint_as_float(hv.y << 16), __uint_as_float(hv.y & 0xffff0000u)} * ALPHA; }
                unsigned yv[2][4][4];
#pragma unroll
                for (int q = 0; q < 2; ++q)
#pragma unroll
                    for (int k = 0; k < 4; ++k) { const size_t gr = (size_t)tstart[ex[q][k]] * 256 + pos[q][k];
#pragma unroll
                        for (int jj = 0; jj < 4; ++jj) yv[q][k][jj] = *(const unsigned*)((const unsigned char*)YS + gr * 1024 + 4 * lz + 256 * jj); }
                __builtin_amdgcn_sched_barrier(0);
#pragma unroll
                for (int q = 0; q < 2; ++q)
#pragma unroll
                    for (int k = 0; k < 4; ++k) { const float g8 = gt[q][k] * 0.125f;
#pragma unroll
                        for (int jj = 0; jj < 4; ++jj) { const u32x2 bw_ = *(const LAS u32x2*)(lds + 65536 + ex[q][k] * 2048 + 8 * lz + 512 * jj);
                            const f32x4 bd = {__uint_as_float(bw_.x << 16), __uint_as_float(bw_.x & 0xffff0000u), __uint_as_float(bw_.y << 16), __uint_as_float(bw_.y & 0xffff0000u)};
                            const f32x2 lo = __builtin_amdgcn_cvt_pk_f32_fp8((int)yv[q][k][jj], false), hi = __builtin_amdgcn_cvt_pk_f32_fp8((int)yv[q][k][jj], true);
                            v[q][jj][0] += g8 * lo.x + gt[q][k] * bd[0]; v[q][jj][1] += g8 * lo.y + gt[q][k] * bd[1]; v[q][jj][2] += g8 * hi.x + gt[q][k] * bd[2]; v[q][jj][3] += g8 * hi.y + gt[q][k] * bd[3]; }
                        __builtin_amdgcn_sched_barrier(0); }
#pragma unroll
                for (int q = 0; q < 2; ++q) { const int row = rowa + q;
                    float s = 0.f;
#pragma unroll
                    for (int jj = 0; jj < 4; ++jj) s += (v[q][jj][0] + v[q][jj][1]) + (v[q][jj][2] + v[q][jj][3]);
                    const float mean = wave_sum(s) * (1.0f / D); float s2 = 0.f;
#pragma unroll
                    for (int jj = 0; jj < 4; ++jj) { v[q][jj] = v[q][jj] - mean; s2 += (v[q][jj][0] * v[q][jj][0] + v[q][jj][1] * v[q][jj][1]) + (v[q][jj][2] * v[q][jj][2] + v[q][jj][3] * v[q][jj][3]); }
                    const float rstd = 1.0f / sqrtf(wave_sum(s2) * (1.0f / D) + LN_EPS);
#pragma unroll
                    for (int jj = 0; jj < 4; ++jj) { const f32x4 gq = *(const LAS f32x4*)(lgs + 4 * lz + 256 * jj), bq = *(const LAS f32x4*)(lbs + 4 * lz + 256 * jj);
                        v[q][jj] = v[q][jj] * rstd * gq + bq;
                        if constexpr (layer == NLAYER - 1) *(f32x4*)(Hf + (size_t)row * D + 4 * lz + 256 * jj) = v[q][jj];
                        if constexpr (layer < NLAYER - 1) { u32x2 w; w.x = cvt_pk_bf16(v[q][jj][0], v[q][jj][1]); w.y = cvt_pk_bf16(v[q][jj][2], v[q][jj][3]); *(u32x2*)(HB + (size_t)row * D + 4 * lz + 256 * jj) = w; }
                        if constexpr ((layer + 1) % 3 != 0 && layer + 1 < NLAYER) { int w8 = 0; w8 = __builtin_amdgcn_cvt_pk_fp8_f32(v[q][jj][0], v[q][jj][1], w8, false); w8 = __builtin_amdgcn_cvt_pk_fp8_f32(v[q][jj][2], v[q][jj][3], w8, true); *(int*)(HB8 + (size_t)row * D + 4 * lz + 256 * jj) = w8; } }
                    if constexpr ((layer + 1) % 3 == 2) {
                        float r[16];
#pragma unroll
                        for (int i = 0; i < 16; ++i) { r[i] = 0.f;
#pragma unroll
                            for (int jj = 0; jj < 4; ++jj) { const f32x4 w4 = *(const LAS f32x4*)((LAS float*)lds + i * D + 4 * lz + 256 * jj); r[i] += (v[q][jj][0] * w4[0] + v[q][jj][1] * w4[1]) + (v[q][jj][2] * w4[2] + v[q][jj][3] * w4[3]); } }
#pragma unroll
                        for (int q8 = 0; q8 < 8; ++q8) { const bool hi_ = (lz & 32) != 0; const float keep = hi_ ? r[q8 + 8] : r[q8], send = hi_ ? r[q8] : r[q8 + 8]; r[q8] = keep + __shfl_xor(send, 32); }
#pragma unroll
                        for (int q8 = 0; q8 < 4; ++q8) { const bool hi_ = (lz & 16) != 0; const float keep = hi_ ? r[q8 + 4] : r[q8], send = hi_ ? r[q8] : r[q8 + 4]; r[q8] = keep + __shfl_xor(send, 16); }
#pragma unroll
                        for (int q8 = 0; q8 < 2; ++q8) { const bool hi_ = (lz & 8) != 0; const float keep = hi_ ? r[q8 + 2] : r[q8], send = hi_ ? r[q8] : r[q8 + 2]; r[q8] = keep + __shfl_xor(send, 8); }
                        { const bool hi_ = (lz & 4) != 0; const float keep = hi_ ? r[1] : r[0], send = hi_ ? r[0] : r[1]; r[0] = keep + __shfl_xor(send, 4); }
                        r[0] += __shfl_xor(r[0], 2); r[0] += __shfl_xor(r[0], 1);
                        if ((lz & 3) == 0) GKL[(size_t)row * 16 + (lz >> 2)] = r[0];
                    }
                }
            }
            __syncthreads();
        PH_END
}

__global__ void __launch_bounds__(NTHR, 2) fwd_kernel(Args args) {
    extern __shared__ __attribute__((aligned(16))) unsigned char lds_raw[];
    LAS unsigned char* lds = (LAS unsigned char*)lds_raw;
    const int G = gridDim.x, bx = blockIdx.x;
    volatile LAS unsigned* MISC = (volatile LAS unsigned*)(lds + MISC_OFF);
    if (threadIdx.x < 64) MISC[threadIdx.x] = 0u;
    __syncthreads();
    const int lo = args.ph_lo, hi = args.ph_hi;
    XcdBarrier bar; bar.bar = (unsigned*)((gu32*)(args.ws + WS_CTL) + CW_BAR); bar.x = 0; bar.st = MISC;
    if (hi - lo > 1) { bar = xcd_barrier_post(bar.bar, MISC);
        if (threadIdx.x == 0 && ((xb_xcc_id() & 7u) != (unsigned)(bx & 7) || G != 256)) (void)xb_add(&bar.bar[XB_MIS], 1u); }
    int pid = 0;
    PH_BEGIN
        conv_mats(IN_(2), 2, D, 3072, 3072, (bf16*)(WSP + WS_AIN), false, gw, NGW, lane);
        for (int it = gw; it < 3072; it += NGW) {
            if (it < 1024) conv_fp8(IN_(4), (unsigned char*)(WSP + WS_BIN), 4096, it, false, (float)(1 << FP8_GU_SHIFT), lane);
            else if (it < 1792) conv_fp8(IN_(10), (unsigned char*)(WSP + WS_CIN), 3072, it - 1024, false, (float)(1 << FP8_GU_SHIFT), lane, CIN);
            else if (it < 2304) conv_fp8(IN_(9), (unsigned char*)(WSP + WS_BOUT), D, it - 1792, false, (float)(1 << FP8_DN_SHIFT), lane, 0, BW);
            else if (it < 2816) conv_fp8(IN_(3), (unsigned char*)(WSP + WS_AOUT), D, it - 2304, false, (float)(1 << FP8_DN_SHIFT), lane);
            else conv_fp8(IN_(14), (unsigned char*)(WSP + WS_COUT), D, it - 2816, false, (float)(1 << FP8_DN_SHIFT), lane); }
        for (int i = bx * NTHR + tid; i < NLAYER * NE * D; i += G * NTHR) { const int l = i / (NE * D), r = i % (NE * D), e = r / D, d = r % D; const float w = IN_(17)[(size_t)l * D * NE + (size_t)d * NE + e];
            const bf16 hi = f2bf(w); WRH[i] = hi; WRL[i] = f2bf(w - bf2f(hi)); }
        for (int i = bx * NTHR + tid; i < 16 * D; i += G * NTHR) { const int c = i / D, d = i % D; W16T[i] = IN_(10)[(size_t)d * CIN + 3072 + c]; }
        for (size_t i = (size_t)(bx * NTHR + tid); i < (size_t)T * D / 4; i += (size_t)G * NTHR) { const f32x4 v = ((const f32x4*)IN_(0))[i]; u32x2 w; w.x = cvt_pk_bf16(v[0], v[1]); w.y = cvt_pk_bf16(v[2], v[3]); ((u32x2*)HB)[i] = w; }
    PH_END

    layer_body<0>(lo, hi, G, bx, lds, bar);
    layer_body<1>(lo, hi, G, bx, lds, bar);
    layer_body<2>(lo, hi, G, bx, lds, bar);
    layer_body<3>(lo, hi, G, bx, lds, bar);
}

static int count_phases() { int n = 1; for (int l = 0; l < NLAYER; ++l) { const int m = l % 3; n += (m == 0 ? 3 : (m == 1 ? 3 : 5)) + 4; } return n; }

extern "C" void kernel_launch(void* const* d_in, const int* in_sizes, int n_in, void* d_out, int out_size, void* d_ws, size_t ws_size, hipStream_t stream) {
    static int grid = 0;
    if (grid == 0) {
        if (n_in != 23 || out_size != T * D || ws_size < WS_END) { fprintf(stderr, "kernel_launch: unexpected problem (n_in %d out %d ws %zu)\n", n_in, out_size, ws_size); grid = -1; return; }
        int dev = 0, cus = 0;
        hipGetDevice(&dev); hipDeviceGetAttribute(&cus, hipDeviceAttributeMultiprocessorCount, dev);
        if (hipFuncSetAttribute((const void*)fwd_kernel, hipFuncAttributeMaxDynamicSharedMemorySize, LDS_BYTES) != hipSuccess) { fprintf(stderr, "kernel_launch: hipFuncSetAttribute failed\n"); grid = -1; return; }
        int per_cu = 0;
        if (hipOccupancyMaxActiveBlocksPerMultiprocessor(&per_cu, (const void*)fwd_kernel, NTHR, LDS_BYTES) != hipSuccess || per_cu < 1) fprintf(stderr, "kernel_launch: occupancy query says %d\n", per_cu);
        (void)hipGetLastError();
        grid = 256; (void)cus;
    }
    if (grid < 0) return;
    hipMemsetAsync((char*)d_ws + WS_CTL, 0, CTL_ZERO_BYTES, stream);
    Args a{};
    for (int i = 0; i < 23; ++i) a.in[i] = (const float*)d_in[i];
    a.out = (float*)d_out; a.ws = (unsigned char*)d_ws;
    const int NP = count_phases();
#if MK_ONE_LAUNCH
    a.ph_lo = 0; a.ph_hi = NP;
    hipLaunchKernelGGL(fwd_kernel, dim3(grid), dim3(NTHR), LDS_BYTES, stream, a);
#else
    for (int p = 0; p < NP; ++p) { a.ph_lo = p; a.ph_hi = p + 1; hipLaunchKernelGGL(fwd_kernel, dim3(grid), dim3(NTHR), LDS_BYTES, stream, a); }
#endif
}
```

```cpp
#include <hip/hip_runtime.h>
#include <cstdio>
#include <cstdint>

#ifndef PROBE_MASK
#define PROBE_MASK 0ull
#endif
#ifndef ATT_REP
#define ATT_REP 1
#endif
#ifndef MK_ONE_LAUNCH
#define MK_ONE_LAUNCH 1
#endif

#define GAS __attribute__((address_space(1)))
#define LAS __attribute__((address_space(3)))
typedef unsigned short bf16;
typedef short bf16x8 __attribute__((ext_vector_type(8)));
typedef float f32x4 __attribute__((ext_vector_type(4)));
typedef float f32x2 __attribute__((ext_vector_type(2)));
typedef unsigned u32x4 __attribute__((ext_vector_type(4)));
typedef unsigned u32x2 __attribute__((ext_vector_type(2)));
typedef GAS unsigned gu32;
typedef int i32x4 __attribute__((ext_vector_type(4)));
typedef int i32x8 __attribute__((ext_vector_type(8)));
#define FP8_GU_SHIFT 6
#define FP8_GU_SCALE 0x79797979
#define FP8_DN_SHIFT 7
#define FP8_DN_SCALE 0x7b7b7b7b

constexpr int BATCH = 8, SEQ = 2048, T = BATCH * SEQ, D = 1024, NLAYER = 4, NE = 32, TOPK = 4;
constexpr int AH = 8, ADH = 128, MBLK = 256;
constexpr int BW = 2048, BG = 8, BCH = 128;
constexpr int CH = 4, CDK = 128, CDV = 256, CKEY = 512, CVAL = 1024, CRANK = 16, CIN = 3088;
constexpr float ALPHA = 1.6817928305074292f;
constexpr float LN_EPS = 1e-5f;
constexpr int NWAVES = 8, NTHR = 512;

constexpr size_t MiB = 1u << 20;
constexpr size_t WS_CTL = 0, CTL_ZERO_BYTES = 64 * 1024;
constexpr size_t WS_WRT = 1 * MiB;
constexpr size_t WS_AIN = 2 * MiB;
constexpr size_t WS_AOUT = 14 * MiB;
constexpr size_t WS_BIN = 18 * MiB;
constexpr size_t WS_BOUT = 26 * MiB;
constexpr size_t WS_CIN = 30 * MiB;
constexpr size_t WS_COUT = 36 * MiB;
constexpr size_t WS_GU = 64 * MiB;
constexpr size_t WS_DN = 576 * MiB;
constexpr size_t WS_HB = 832 * MiB;
constexpr size_t WS_U = 864 * MiB;
constexpr size_t WS_BIG1 = 928 * MiB;
constexpr size_t WS_BIG2 = 1056 * MiB;
constexpr size_t WS_BIG3 = 1120 * MiB;
constexpr size_t WS_ACT = 1248 * MiB;
constexpr size_t WS_YS = 1392 * MiB;
constexpr size_t WS_TOK = 1536 * MiB;
constexpr size_t WS_SELE = 1538 * MiB;
constexpr size_t WS_SELP = WS_SELE + 256 * 1024;
constexpr size_t WS_SELG = WS_SELP + 256 * 1024;
constexpr size_t WS_KMEAN = 1540 * MiB;
constexpr size_t WS_STATS = 1541 * MiB;
constexpr size_t WS_GKL = 1545 * MiB;
constexpr size_t WS_W16T = WS_WRT + 512 * 1024;
constexpr size_t WS_END = 1600 * MiB;
constexpr int CW_BAR = 4096;
constexpr int CW_CV = 12288;
constexpr int CW_CNT = 8192;

constexpr int RING_BYTES = 131072;
constexpr int MISC_OFF = RING_BYTES;
constexpr int IDX_OFF = RING_BYTES + 4096;
constexpr int LDS_BYTES = 147456;
constexpr int MAXU = 12;

__device__ __forceinline__ float bf2f(bf16 b) { return __uint_as_float(((unsigned)b) << 16); }
__device__ __forceinline__ unsigned cvt_pk_bf16(float lo, float hi) { unsigned r; asm volatile("v_cvt_pk_bf16_f32 %0, %1, %2" : "=v"(r) : "v"(lo), "v"(hi)); return r; }
__device__ __forceinline__ bf16 f2bf(float f) { return (bf16)(cvt_pk_bf16(f, 0.f) & 0xffffu); }
__device__ __forceinline__ float wave_sum(float v) {
#pragma unroll
    for (int o = 1; o < 64; o <<= 1) v += __shfl_xor(v, o);
    return v;
}
__device__ __forceinline__ float wave_max(float v) {
#pragma unroll
    for (int o = 1; o < 64; o <<= 1) v = fmaxf(v, __shfl_xor(v, o));
    return v;
}
__device__ __forceinline__ int opaque_tid() { int t = threadIdx.x; asm volatile("" : "+v"(t)); return t; }
#define LDS_WAIT() asm volatile("s_waitcnt lgkmcnt(0)" ::: "memory")
#define VM_WAIT() asm volatile("s_waitcnt vmcnt(0)" ::: "memory")

namespace pg8 {
constexpr int BM = 256, BK = 64, HALF = 128, HTB = HALF * BK * 2, STAGE_BYTES = 8 * HTB, NXCD = 8, WGM = 8;
__host__ __device__ __forceinline__ int lds_byte(int r, int c) { const int st = (r >> 4) * 2 + (c >> 5), rr = r & 15, cc = c & 31, ob = rr * 64 + cc * 2; return st * 1024 + (ob ^ (((ob >> 9) & 1) << 5)); }
__host__ __device__ __forceinline__ void stage_rc(int b, int& R, int& C) { const int st = b / 1024, sb = b % 1024, swz = sb ^ (((sb >> 9) & 1) << 5); R = (st >> 1) * 16 + swz / 64; C = (st & 1) * 32 + (swz % 64) / 2; }
__host__ __device__ __forceinline__ int perm32(int rho) { const int n = rho >> 4, i = rho & 15; return 8 * (i >> 2) + 4 * n + (i & 3); }

struct Unit { int pm, pn, e, pnl; };
struct Gemm { const bf16* A; const bf16* Bt; int K; int scw = 0x7f7f7f7f; };

struct StaticOrder {
    int nM, nN, nwg, G, c;
    __device__ void init(int nM_, int nN_, int G_, int c_) { nM = nM_; nN = nN_; nwg = nM * nN; G = G_; c = c_; }
    __device__ __forceinline__ bool next(int i, Unit& u) const {
        const long L = (long)i * G + c; if (L >= nwg) return false;
        int wgid = (int)L; { const int q = nwg / NXCD, r = nwg % NXCD, xcd = wgid % NXCD, off = wgid / NXCD; wgid = (xcd < r ? xcd * (q + 1) : r * (q + 1) + (xcd - r) * q) + off; }
        const int nig = WGM * nN, gid = wgid / nig, fm = gid * WGM, gsz = (nM - fm) < WGM ? (nM - fm) : WGM;
        u.pm = fm + ((wgid % nig) % gsz); u.pn = (wgid % nig) / gsz; u.e = 0; u.pnl = u.pn; return true;
    }
    __device__ __forceinline__ int rowidx(int, int) const { return 0; }
};
struct MoeOrder {
    StaticOrder so; const LAS int* tile_e; const LAS int* idx;
    __device__ __forceinline__ bool next(int i, Unit& u) const {
        const int nN = so.nN, nM = so.nM;
        int pmv, pnv;
        if ((so.G & 7) != 0) { Unit t_; t_.pm = 0; t_.pn = 0; if (!so.next(i, t_)) return false; pmv = t_.pm; pnv = t_.pn; }
        else { const int x = so.c & 7, j = so.c >> 3, per = so.G >> 3, t0 = (x * nM) >> 3, nl = (((x + 1) * nM) >> 3) - t0, Lx = i * per + j;
            if (Lx >= nl * nN) return false;
            constexpr int MW = 4;
            const int nig = MW * nN, gid = Lx / nig, fm = gid * MW, gsz = (nl - fm) < MW ? (nl - fm) : MW, idx = Lx % nig;
            pmv = t0 + fm + idx % gsz; pnv = idx / gsz; }
        u.pm = pmv; u.e = tile_e[pmv]; u.pnl = pnv; u.pn = u.e * nN + pnv; return true;
    }
    __device__ __forceinline__ int rowidx(int i, int r) const { return idx[i * 256 + r]; }
};

__device__ __forceinline__ f32x2 gelu_pk(f32x2 v) {
    const f32x2 av = __builtin_elementwise_abs(v), d = av * 0.2316418882f + 1.0f;
    f32x2 t; t.x = __builtin_amdgcn_rcpf(d.x); t.y = __builtin_amdgcn_rcpf(d.y);
    f32x2 q = t * 0.5307027145f + (-0.7265760135f); q = q * t + 0.7107068705f; q = q * t + (-0.142248368f); q = q * t + 0.127414796f; q = q * t;
    const f32x2 s = (v * v) * (-0.72134752044f);
    f32x2 e; e.x = __builtin_amdgcn_exp2f(s.x); e.y = __builtin_amdgcn_exp2f(s.y);
    const f32x2 m = v * (q * e), r = v - m;
    f32x2 o; o.x = v.x < 0.f ? m.x : r.x; o.y = v.y < 0.f ? m.y : r.y; return o;
}

struct EpiBf16 {
    static constexpr bool PERM = true;
    bf16* O; int ldc; float* KP = nullptr;
    __device__ __forceinline__ void operator()(const f32x4 (&acc)[2][2][4][2], const Unit& u, int wr, int wc, int fr, int fq) const {
        const int row0 = u.pm * BM + wr * 64 + fr, col0 = u.pnl * BM + wc * 32 + 8 * fq;
        if (KP != nullptr && u.pnl >= 4 && u.pnl < 8) {
#pragma unroll
            for (int bj = 0; bj < 2; ++bj)
#pragma unroll
                for (int n = 0; n < 2; ++n) { f32x4 cs = acc[0][bj][0][n];
#pragma unroll
                    for (int m = 1; m < 4; ++m) cs += acc[0][bj][m][n];
#pragma unroll
                    for (int m = 0; m < 4; ++m) cs += acc[1][bj][m][n];
#pragma unroll
                    for (int e = 0; e < 4; ++e) { float v = cs[e]; v += __shfl_xor(v, 1); v += __shfl_xor(v, 2); v += __shfl_xor(v, 4); v += __shfl_xor(v, 8); cs[e] = v; }
                    if (fr == 0) *(f32x4*)(KP + ((size_t)u.pm * 2 + wr) * 1024 + (u.pnl - 4) * BM + wc * 32 + 8 * fq + bj * HALF + 4 * n) = cs; }
        }
#pragma unroll
        for (int ai = 0; ai < 2; ++ai)
#pragma unroll
            for (int m = 0; m < 4; ++m) { bf16* rowp = O + (size_t)(row0 + ai * HALF + m * 16) * ldc + col0;
#pragma unroll
                for (int bj = 0; bj < 2; ++bj) { const f32x4 v0 = acc[ai][bj][m][0], v1 = acc[ai][bj][m][1];
                    u32x4 w; w.x = cvt_pk_bf16(v0[0], v0[1]); w.y = cvt_pk_bf16(v0[2], v0[3]); w.z = cvt_pk_bf16(v1[0], v1[1]); w.w = cvt_pk_bf16(v1[2], v1[3]);
                    *(u32x4*)(rowp + bj * HALF) = w; } }
    }
};
struct EpiYs8 {
    static constexpr bool PERM = true;
    unsigned char* O;
    __device__ __forceinline__ void operator()(const f32x4 (&acc)[2][2][4][2], const Unit& u, int wr, int wc, int fr, int fq) const {
        const int row0 = u.pm * BM + wr * 64 + fr, col0 = u.pnl * BM + wc * 32 + 8 * fq;
#pragma unroll
        for (int ai = 0; ai < 2; ++ai)
#pragma unroll
            for (int m = 0; m < 4; ++m) { unsigned char* rowp = O + (size_t)(row0 + ai * HALF + m * 16) * 1024 + col0;
#pragma unroll
                for (int bj = 0; bj < 2; ++bj) { const f32x4 v0 = acc[ai][bj][m][0], v1 = acc[ai][bj][m][1];
                    int w0 = 0, w1 = 0; w0 = __builtin_amdgcn_cvt_pk_fp8_f32(v0[0], v0[1], w0, false); w0 = __builtin_amdgcn_cvt_pk_fp8_f32(v0[2], v0[3], w0, true);
                    w1 = __builtin_amdgcn_cvt_pk_fp8_f32(v1[0], v1[1], w1, false); w1 = __builtin_amdgcn_cvt_pk_fp8_f32(v1[2], v1[3], w1, true);
                    u32x2 w; w.x = (unsigned)w0; w.y = (unsigned)w1; *(u32x2*)(rowp + bj * HALF) = w; } }
    }
};
struct EpiResid {
    static constexpr bool PERM = true;
    const bf16* H; bf16* U; float alpha;
    __device__ __forceinline__ void operator()(const f32x4 (&acc)[2][2][4][2], const Unit& u, int wr, int wc, int fr, int fq) const {
        const int row0 = u.pm * BM + wr * 64 + fr, col0 = u.pnl * BM + wc * 32 + 8 * fq;
#pragma unroll
        for (int ai = 0; ai < 2; ++ai)
#pragma unroll
            for (int m = 0; m < 4; ++m) { const size_t off = (size_t)(row0 + ai * HALF + m * 16) * D + col0;
#pragma unroll
                for (int bj = 0; bj < 2; ++bj) { const u32x4 hv = *(const u32x4*)(H + off + bj * HALF); const f32x4 v0 = acc[ai][bj][m][0], v1 = acc[ai][bj][m][1];
                    const f32x2 r0 = (f32x2){__uint_as_float(hv.x << 16), __uint_as_float(hv.x & 0xffff0000u)} * alpha + (f32x2){v0[0], v0[1]}, r1 = (f32x2){__uint_as_float(hv.y << 16), __uint_as_float(hv.y & 0xffff0000u)} * alpha + (f32x2){v0[2], v0[3]};
                    const f32x2 r2 = (f32x2){__uint_as_float(hv.z << 16), __uint_as_float(hv.z & 0xffff0000u)} * alpha + (f32x2){v1[0], v1[1]}, r3 = (f32x2){__uint_as_float(hv.w << 16), __uint_as_float(hv.w & 0xffff0000u)} * alpha + (f32x2){v1[2], v1[3]};
                    u32x4 w; w.x = cvt_pk_bf16(r0.x, r0.y); w.y = cvt_pk_bf16(r1.x, r1.y); w.z = cvt_pk_bf16(r2.x, r2.y); w.w = cvt_pk_bf16(r3.x, r3.y);
                    *(u32x4*)(U + off + bj * HALF) = w; } }
    }
};
struct EpiGelu {
    static constexpr bool PERM = true;
    bf16* Z; float* ST;
    __device__ __forceinline__ void operator()(const f32x4 (&acc)[2][2][4][2], const Unit& u, int wr, int wc, int fr, int fq) const {
        const int row0 = u.pm * BM + wr * 64 + fr, col0 = u.pnl * BM + wc * 32 + 8 * fq;
#pragma unroll
        for (int ai = 0; ai < 2; ++ai)
#pragma unroll
            for (int m = 0; m < 4; ++m) { const int row = row0 + ai * HALF + m * 16; bf16* rowp = Z + (size_t)row * 4096 + col0; float s = 0.f, q = 0.f;
#pragma unroll
                for (int bj = 0; bj < 2; ++bj) { const f32x4 v0 = acc[ai][bj][m][0], v1 = acc[ai][bj][m][1];
                    const f32x2 a = gelu_pk((f32x2){v0[0], v0[1]}), b = gelu_pk((f32x2){v0[2], v0[3]}), c = gelu_pk((f32x2){v1[0], v1[1]}), d = gelu_pk((f32x2){v1[2], v1[3]});
                    s += (a.x + a.y) + (b.x + b.y) + (c.x + c.y) + (d.x + d.y);
                    q += (a.x * a.x + a.y * a.y) + (b.x * b.x + b.y * b.y) + (c.x * c.x + c.y * c.y) + (d.x * d.x + d.y * d.y);
                    u32x4 w; w.x = cvt_pk_bf16(a.x, a.y); w.y = cvt_pk_bf16(b.x, b.y); w.z = cvt_pk_bf16(c.x, c.y); w.w = cvt_pk_bf16(d.x, d.y);
                    *(u32x4*)(rowp + bj * HALF) = w; }
                if (u.pnl >= 8) { s += __shfl_xor(s, 16); s += __shfl_xor(s, 32); q += __shfl_xor(q, 16); q += __shfl_xor(q, 32);
                    if (fq == 0) *(f32x2*)(ST + ((size_t)row * 32 + (u.pnl - 8) * 4 + wc) * 2) = (f32x2){s, q}; } }
    }
};
struct EpiSwiglu {
    static constexpr bool PERM = true;
    unsigned char* ACT; const float* bgu;
    __device__ __forceinline__ void operator()(const f32x4 (&acc)[2][2][4][2], const Unit& u, int wr, int wc, int fr, int fq) const {
        const int row0 = u.pm * BM + wr * 64 + fr, col0 = u.pnl * HALF + wc * 32 + 8 * fq;
        const float* bp = bgu + (size_t)u.e * 2048 + col0;
        f32x2 bg[4], bu[4];
        { const f32x4 g0 = *(const f32x4*)(bp), g1 = *(const f32x4*)(bp + 4), u0 = *(const f32x4*)(bp + 1024), u1 = *(const f32x4*)(bp + 1028);
          bg[0] = (f32x2){g0[0], g0[1]}; bg[1] = (f32x2){g0[2], g0[3]}; bg[2] = (f32x2){g1[0], g1[1]}; bg[3] = (f32x2){g1[2], g1[3]};
          bu[0] = (f32x2){u0[0], u0[1]} + 1.0f; bu[1] = (f32x2){u0[2], u0[3]} + 1.0f; bu[2] = (f32x2){u1[0], u1[1]} + 1.0f; bu[3] = (f32x2){u1[2], u1[3]} + 1.0f; }
#pragma unroll
        for (int ai = 0; ai < 2; ++ai)
#pragma unroll
            for (int m = 0; m < 4; ++m) { unsigned char* rowp = ACT + (size_t)(row0 + ai * HALF + m * 16) * 1024 + col0;
                f32x2 o[4];
#pragma unroll
                for (int p = 0; p < 4; ++p) { const int n = p >> 1, j0 = 2 * (p & 1);
                    f32x2 g = (f32x2){acc[ai][0][m][n][j0], acc[ai][0][m][n][j0 + 1]} + bg[p], up = (f32x2){acc[ai][1][m][n][j0], acc[ai][1][m][n][j0 + 1]} + bu[p];
                    g.x = fminf(g.x, 7.0f); g.y = fminf(g.y, 7.0f);
                    up.x = __builtin_amdgcn_fmed3f(up.x, -6.0f, 8.0f); up.y = __builtin_amdgcn_fmed3f(up.y, -6.0f, 8.0f);
                    const f32x2 t = g * (-1.702f * 1.44269504f);
                    f32x2 d; d.x = __builtin_amdgcn_exp2f(t.x); d.y = __builtin_amdgcn_exp2f(t.y); d = d + 1.0f;
                    f32x2 r; r.x = __builtin_amdgcn_rcpf(d.x); r.y = __builtin_amdgcn_rcpf(d.y);
                    o[p] = (g * r) * up; }
                int w0 = 0, w1 = 0; w0 = __builtin_amdgcn_cvt_pk_fp8_f32(o[0].x, o[0].y, w0, false); w0 = __builtin_amdgcn_cvt_pk_fp8_f32(o[1].x, o[1].y, w0, true);
                w1 = __builtin_amdgcn_cvt_pk_fp8_f32(o[2].x, o[2].y, w1, false); w1 = __builtin_amdgcn_cvt_pk_fp8_f32(o[3].x, o[3].y, w1, true);
                u32x2 w; w.x = (unsigned)w0; w.y = (unsigned)w1; *(u32x2*)rowp = w; }
    }
};

template <class Epi, class Sched, bool ALIGN_EPI, bool GATHER, bool FP8 = false>
__device__ __forceinline__ void gemm_phase(LAS unsigned char* lds, const Gemm g, const Sched& S, const Epi& E) {
    const int tid = opaque_tid(), wid = __builtin_amdgcn_readfirstlane(tid >> 6), lane = tid & 63, wr = wid >> 2, wc = wid & 3, fr = lane & 15, fq = lane >> 4;
    const int K = g.K, nt = K / 128;
    int scw_ = g.scw, scx_ = 0x7f7f7f7f; if constexpr (FP8) { asm volatile("" : "+v"(scw_), "+v"(scx_)); }
    unsigned voffA[2], voffB[2]; int RA[2]; unsigned cA2[2];
#pragma unroll
    for (int i = 0; i < 2; ++i) { int R, C; stage_rc(tid * 16 + i * 8192, R, C); const int Rb = Epi::PERM ? ((R & ~31) + perm32(R & 31)) : R;
        voffA[i] = (unsigned)(R * K + C * 2); voffB[i] = (unsigned)(Rb * K + C * 2); RA[i] = R; cA2[i] = (unsigned)C * 2u; }
    const size_t kstep = (size_t)(BK * 2);
    const size_t hstepB = (size_t)HALF * K;
    const size_t hstepA = GATHER ? 0 : hstepB;
    const size_t tstep = 2 * hstepB;
    const unsigned ldsw = (unsigned)wid * 1024u;
    const int aoff = lds_byte(wr * 64 + fr, fq * 8), boff = lds_byte(wc * 32 + fr, fq * 8);
#define PG8_SA(b, h) (((b) * 2 + (h)) * HTB)
#define PG8_SB(b, h) ((4 + (b) * 2 + (h)) * HTB)
#define PG8_STAGE2(bufoff, gbase, o0, o1) do { \
        __builtin_amdgcn_global_load_lds((const unsigned*)((const char*)(gbase) + (o0)), (LAS unsigned*)(lds + (bufoff) + ldsw), 16, 0, 0); \
        __builtin_amdgcn_global_load_lds((const unsigned*)((const char*)(gbase) + (o1)), (LAS unsigned*)(lds + (bufoff) + ldsw + 8192), 16, 0, 0); } while (0)
#define PG8_STAGEB(bufoff, gbase) PG8_STAGE2(bufoff, gbase, voffB[0], voffB[1])
#define PG8_LDA(dst, b, h) do { _Pragma("unroll") for (int m = 0; m < 4; ++m) _Pragma("unroll") for (int k = 0; k < 2; ++k) dst[m][k] = *(const LAS bf16x8*)(lds + PG8_SA(b, h) + aoff + m * 2048 + k * 1024); } while (0)
#define PG8_LDB(dst, b, h) do { _Pragma("unroll") for (int n = 0; n < 2; ++n) _Pragma("unroll") for (int k = 0; k < 2; ++k) dst[n][k] = *(const LAS bf16x8*)(lds + PG8_SB(b, h) + boff + n * 2048 + k * 1024); } while (0)
#define PG8_CAT(x, y) __builtin_shufflevector(__builtin_bit_cast(i32x4, x), __builtin_bit_cast(i32x4, y), 0, 1, 2, 3, 4, 5, 6, 7)
#define PG8_MMA(ai, bj, At, Bt) do { if constexpr (FP8) __builtin_amdgcn_sched_barrier(0); __builtin_amdgcn_s_setprio(1); _Pragma("unroll") for (int m = 0; m < 4; ++m) _Pragma("unroll") for (int n = 0; n < 2; ++n) { \
        if constexpr (FP8) { const i32x8 a8_ = PG8_CAT(Bt[n][0], Bt[n][1]), b8_ = PG8_CAT(At[m][0], At[m][1]); \
            asm volatile("v_mfma_scale_f32_16x16x128_f8f6f4 %0, %1, %2, %0, %3, %4 op_sel_hi:[0,0,0]" : "+v"(acc[ai][bj][m][n]) : "v"(a8_), "v"(b8_), "v"(scw_), "v"(scx_)); } \
        else { _Pragma("unroll") for (int k = 0; k < 2; ++k) acc[ai][bj][m][n] = __builtin_amdgcn_mfma_f32_16x16x32_bf16(Bt[n][k], At[m][k], acc[ai][bj][m][n], 0, 0, 0); } } __builtin_amdgcn_s_setprio(0); if constexpr (FP8) __builtin_amdgcn_sched_barrier(0); } while (0)
#define PG8_WAIT_V(n) asm volatile("s_waitcnt vmcnt(" #n ")" ::: "memory")
#define PG8_WAIT_L(n) asm volatile("s_waitcnt lgkmcnt(" #n ")" ::: "memory")
#define PG8_BAR __builtin_amdgcn_s_barrier()
#define PG8_SCHED __builtin_amdgcn_sched_barrier(0)
    LAS int* utab = (LAS int*)(lds + STAGE_BYTES + 2304);
    if (tid < 16) { Unit u_; const bool ok_ = S.next(tid, u_); utab[tid * 4 + 0] = ok_ ? u_.pm : -1; utab[tid * 4 + 1] = u_.pn; utab[tid * 4 + 2] = u_.e; utab[tid * 4 + 3] = u_.pnl; }
    asm volatile("s_waitcnt lgkmcnt(0)" ::: "memory"); __builtin_amdgcn_s_barrier(); asm volatile("" ::: "memory");
#define PG8_NEXT(i_, u_) ((i_) < 16 && (u_.pm = __builtin_amdgcn_readfirstlane(utab[(i_) * 4 + 0])) >= 0 && (u_.pn = __builtin_amdgcn_readfirstlane(utab[(i_) * 4 + 1]), u_.e = __builtin_amdgcn_readfirstlane(utab[(i_) * 4 + 2]), u_.pnl = __builtin_amdgcn_readfirstlane(utab[(i_) * 4 + 3]), true))
    Unit cur, nxt; int ui = 0;
    if (!PG8_NEXT(0, cur)) return;
    f32x4 acc[2][2][4][2];
#pragma unroll
    for (int a = 0; a < 2; ++a)
#pragma unroll
        for (int b = 0; b < 2; ++b)
#pragma unroll
            for (int m = 0; m < 4; ++m)
#pragma unroll
                for (int n = 0; n < 2; ++n) acc[a][b][m][n] = (f32x4){0.f, 0.f, 0.f, 0.f};
    bf16x8 At[4][2], B0[2][2], B1[2][2];
    unsigned gC[2][2], gN[2][2];
#pragma unroll
    for (int h = 0; h < 2; ++h)
#pragma unroll
        for (int i = 0; i < 2; ++i) { gC[h][i] = GATHER ? ((unsigned)S.rowidx(0, h * HALF + RA[i]) * (unsigned)K + cA2[i]) : voffA[i]; gN[h][i] = gC[h][i]; }
    const char* cA = GATHER ? (const char*)g.A : (const char*)g.A + (size_t)cur.pm * tstep; const char* cB = (const char*)g.Bt + (size_t)cur.pn * tstep;
    PG8_STAGEB(PG8_SB(0, 0), cB); PG8_STAGEB(PG8_SB(0, 1), cB + hstepB); PG8_STAGE2(PG8_SA(0, 0), cA, gC[0][0], gC[0][1]); PG8_STAGE2(PG8_SA(0, 1), cA + hstepA, gC[1][0], gC[1][1]);
    if (wr == 1) PG8_BAR;
    PG8_WAIT_V(2); PG8_BAR;
    PG8_STAGEB(PG8_SB(1, 0), cB + kstep); PG8_STAGE2(PG8_SA(1, 0), cA + kstep, gC[0][0], gC[0][1]); PG8_STAGEB(PG8_SB(1, 1), cB + hstepB + kstep);
    PG8_WAIT_V(6); PG8_BAR;
    for (;;) {
        const bool has_next = PG8_NEXT(ui + 1, nxt);
        const char* nA = GATHER ? cA : (has_next ? (const char*)g.A + (size_t)nxt.pm * tstep : cA); const char* nB = has_next ? (const char*)g.Bt + (size_t)nxt.pn * tstep : cB;
        if (GATHER) {
#pragma unroll
            for (int h = 0; h < 2; ++h)
#pragma unroll
                for (int i = 0; i < 2; ++i) gN[h][i] = has_next ? ((unsigned)S.rowidx(ui + 1, h * HALF + RA[i]) * (unsigned)K + cA2[i]) : gC[h][i];
        }
#pragma unroll 1
        for (int t = 0; t < nt; t += 2) {
            const bool last = (t == nt - 2);
            const char* a1 = cA + (size_t)(t + 1) * kstep;
            const char* a2 = last ? nA : cA + (size_t)(t + 2) * kstep; const char* b2 = last ? nB : cB + (size_t)(t + 2) * kstep;
            const char* a3 = a2 + kstep; const char* b3 = b2 + kstep;
            unsigned x00, x01, x10, x11;
            if (GATHER) { x00 = last ? gN[0][0] : gC[0][0]; x01 = last ? gN[0][1] : gC[0][1]; x10 = last ? gN[1][0] : gC[1][0]; x11 = last ? gN[1][1] : gC[1][1]; }
            else { x00 = voffA[0]; x01 = voffA[1]; x10 = voffA[0]; x11 = voffA[1]; }
            PG8_LDB(B0, 0, 0); PG8_LDB(B1, 0, 1); PG8_SCHED; PG8_LDA(At, 0, 0); PG8_STAGE2(PG8_SA(1, 1), a1 + hstepA, gC[1][0], gC[1][1]);
            PG8_WAIT_V(8); PG8_WAIT_L(0); PG8_BAR; PG8_MMA(0, 0, At, B0); PG8_MMA(0, 1, At, B1); PG8_BAR; PG8_SCHED;
            PG8_LDA(At, 0, 1); PG8_STAGEB(PG8_SB(0, 0), b2); PG8_STAGEB(PG8_SB(0, 1), b2 + hstepB); PG8_STAGE2(PG8_SA(0, 0), a2, x00, x01);
            PG8_WAIT_V(8); PG8_WAIT_L(0); PG8_BAR; PG8_MMA(1, 0, At, B0); PG8_MMA(1, 1, At, B1); PG8_BAR; PG8_SCHED;
            PG8_LDB(B0, 1, 0); PG8_LDB(B1, 1, 1); PG8_SCHED; PG8_LDA(At, 1, 0); PG8_STAGE2(PG8_SA(0, 1), a2 + hstepA, x10, x11);
            PG8_WAIT_V(8); PG8_WAIT_L(0); PG8_BAR; PG8_MMA(0, 0, At, B0); PG8_MMA(0, 1, At, B1); PG8_BAR; PG8_SCHED;
            PG8_LDA(At, 1, 1); PG8_STAGEB(PG8_SB(1, 0), b3); PG8_STAGEB(PG8_SB(1, 1), b3 + hstepB); PG8_STAGE2(PG8_SA(1, 0), a3, x00, x01);
            PG8_WAIT_V(8); PG8_WAIT_L(0); PG8_BAR; PG8_MMA(1, 0, At, B0); PG8_MMA(1, 1, At, B1); PG8_BAR; PG8_SCHED;
            if (GATHER && last) {
#pragma unroll
                for (int h = 0; h < 2; ++h)
#pragma unroll
                    for (int i = 0; i < 2; ++i) gC[h][i] = gN[h][i];
            }
        }
        if constexpr (ALIGN_EPI) { if (wr == 0) PG8_BAR; }
        if constexpr (FP8) asm volatile("s_nop 15\n\ts_nop 15" ::: "memory");
        E(acc, cur, wr, wc, fr, fq);
        if (!has_next) break;
#pragma unroll
        for (int a = 0; a < 2; ++a)
#pragma unroll
            for (int b = 0; b < 2; ++b)
#pragma unroll
                for (int m = 0; m < 4; ++m)
#pragma unroll
                    for (int n = 0; n < 2; ++n) acc[a][b][m][n] = (f32x4){0.f, 0.f, 0.f, 0.f};
        cur = nxt; cA = nA; cB = nB; ++ui;
        if constexpr (ALIGN_EPI) { if (wr == 1) PG8_BAR; }
    }
    PG8_WAIT_V(0);
    if constexpr (!ALIGN_EPI) { if (wr == 0) PG8_BAR; }
    PG8_BAR;
#undef PG8_SA
#undef PG8_SB
#undef PG8_STAGE2
#undef PG8_STAGEB
#undef PG8_LDA
#undef PG8_LDB
#undef PG8_MMA
#undef PG8_NEXT
#undef PG8_CAT
#undef PG8_WAIT_V
#undef PG8_WAIT_L
#undef PG8_BAR
#undef PG8_SCHED
}
}

#define XB_TMO      128
#define XB_MIS      192
#define XB_XCNT(j)  (256  + 64 * (j))
#define XB_XSUB(j)  (1280 + 64 * (j))
#define XB_XGEN(j)  (2304 + 64 * (j))
#define XB_TOP      3328
#define XB_TOPGEN   3392
#define XCD_BAR_WORDS 3456
#define XB_SPIN_CAP (1u << 18)
__device__ __forceinline__ unsigned xb_ld(unsigned* p)              { return __hip_atomic_load(p, __ATOMIC_RELAXED, __HIP_MEMORY_SCOPE_AGENT); }
__device__ __forceinline__ unsigned xb_add(unsigned* p, unsigned v) { return __hip_atomic_fetch_add(p, v, __ATOMIC_RELAXED, __HIP_MEMORY_SCOPE_AGENT); }
__device__ __forceinline__ unsigned xb_xcc_id() { return (unsigned)__builtin_amdgcn_s_getreg((3 << 11) | 20) & 0xFu; }
#define XB_SPIN(cond, bar) do { unsigned _sp = 0; while (cond) { __builtin_amdgcn_s_sleep(1); \
    if ((++_sp & 255u) == 0u) { if (xb_ld(&(bar)[XB_TMO])) break; if (_sp > XB_SPIN_CAP) { atomicAdd(&(bar)[XB_TMO], 1u); break; } } } } while (0)
struct XcdBarrier { unsigned* bar; unsigned x; volatile LAS unsigned* st; };
__device__ __forceinline__ XcdBarrier xcd_barrier_post(unsigned* bar, volatile LAS unsigned* st) {
    XcdBarrier b; b.bar = bar; b.x = xb_xcc_id(); b.st = st;
    if (threadIdx.x == 0) (void)xb_add(&bar[XB_XCNT(b.x)], 1u);
    return b;
}
__device__ __forceinline__ void xcd_barrier_complete(unsigned* bar, unsigned x, unsigned& nloc, unsigned& nx) {
    const unsigned G = gridDim.x * gridDim.y * gridDim.z;
    unsigned sum, cnt, mine, sp = 0u;
    for (;;) {
        sum = 0u; cnt = 0u; mine = 0u;
#pragma unroll
        for (unsigned j = 0; j < 16; ++j) { const unsigned c = xb_ld(&bar[XB_XCNT(j)]); sum += c; cnt += (c > 0u) ? 1u : 0u; mine = (j == x) ? c : mine; }
        if (sum == G) break;
        __builtin_amdgcn_s_sleep(1);
        if ((++sp & 255u) == 0u) { if (xb_ld(&bar[XB_TMO])) break; if (sp > XB_SPIN_CAP) { atomicAdd(&bar[XB_TMO], 1u); break; } }
    }
    nloc = mine > 0u ? mine : 1u; nx = cnt > 0u ? cnt : 1u;
}
__device__ __noinline__ void xcd_barrier(unsigned* bbar, unsigned bx_, volatile LAS unsigned* bst) {
    XcdBarrier b; b.bar = bbar; b.x = bx_; b.st = bst;
    asm volatile("s_waitcnt vmcnt(0)" ::: "memory");
    __syncthreads();
    if (threadIdx.x == 0) {
        unsigned* bar = b.bar;
        __builtin_amdgcn_s_waitcnt(0);
        unsigned nloc = b.st[0], nx = b.st[1];
        if (nloc == 0u) { xcd_barrier_complete(bar, b.x, nloc, nx); b.st[0] = nloc; b.st[1] = nx; }
        const unsigned old = xb_add(&bar[XB_XSUB(b.x)], 1u);
        const unsigned gen = old / nloc;
        if (old + 1u == (gen + 1u) * nloc) {
            __builtin_amdgcn_fence(__ATOMIC_RELEASE, "agent");
            asm volatile("s_waitcnt vmcnt(0)" ::: "memory");
            const unsigned og = xb_add(&bar[XB_TOP], 1u);
            const unsigned tg = og / nx;
            if (og + 1u == (tg + 1u) * nx) xb_add(&bar[XB_TOPGEN], 1u);
            else XB_SPIN(xb_ld(&bar[XB_TOPGEN]) == tg, bar);
            __builtin_amdgcn_fence(__ATOMIC_ACQUIRE, "agent");
            xb_add(&bar[XB_XGEN(b.x)], 1u);
            asm volatile("s_waitcnt vmcnt(0)" ::: "memory");
        } else {
            XB_SPIN(xb_ld(&bar[XB_XGEN(b.x)]) == gen, bar);
            __builtin_amdgcn_fence(__ATOMIC_ACQUIRE, "agent");
            asm volatile("s_waitcnt vmcnt(0)" ::: "memory");
        }
    }
    __syncthreads();
}

struct ConvItem { const float* src; bf16* dst; };
__device__ __forceinline__ void conv_load(f32x4 (&v)[8], const float* W, int Nsrc, int k0, int n0, int lane) {
    const float* p = W + (size_t)(k0 + 8 * (lane >> 3)) * Nsrc + n0 + 4 * (lane & 7);
#pragma unroll
    for (int i = 0; i < 8; ++i) v[i] = __builtin_nontemporal_load((const f32x4*)(p + (size_t)i * Nsrc));
}
__device__ __forceinline__ void conv_store(const f32x4 (&v)[8], bf16* WT, int K, int drow0, int k0, int lane) {
    bf16* q = WT + (size_t)(drow0 + 4 * (lane & 7)) * K + k0 + 8 * (lane >> 3);
#pragma unroll
    for (int e = 0; e < 4; ++e) { u32x4 o; o.x = cvt_pk_bf16(v[0][e], v[1][e]); o.y = cvt_pk_bf16(v[2][e], v[3][e]); o.z = cvt_pk_bf16(v[4][e], v[5][e]); o.w = cvt_pk_bf16(v[6][e], v[7][e]);
        __builtin_nontemporal_store(o, (u32x4*)(q + (size_t)e * K)); }
}
__device__ __forceinline__ void conv_decode(int it, int K, int Nsrc, int Nc, bool gu, const float* W, bf16* WT, const float*& src, bf16*& dst, int& k0, int& n0, int& drow0) {
    const int nblk = Nc / 32, per = nblk * (K / 64), mat = it / per, r = it % per; k0 = (r / nblk) * 64; n0 = (r % nblk) * 32;
    drow0 = gu ? (256 * ((n0 & 1023) >> 7) + 128 * (n0 >> 10) + (n0 & 127)) : n0; src = W + (size_t)mat * K * Nsrc; dst = WT + (size_t)mat * Nc * K;
}
__device__ __forceinline__ void conv_range(const float* W, int K, int Nsrc, int Nc, bf16* WT, bool gu, int it0, int it1, int stride, int lane) {
    for (int it = it0; it < it1; it += 4 * stride) {
        f32x4 v[4][8]; const float* src[4]; bf16* dst[4]; int k0[4], n0[4], dr[4];
#pragma unroll
        for (int q = 0; q < 4; ++q) { const int iq = it + q * stride; if (iq < it1) { conv_decode(iq, K, Nsrc, Nc, gu, W, WT, src[q], dst[q], k0[q], n0[q], dr[q]); conv_load(v[q], src[q], Nsrc, k0[q], n0[q], lane); } }
#pragma unroll
        for (int q = 0; q < 4; ++q) { const int iq = it + q * stride; if (iq < it1) conv_store(v[q], dst[q], K, dr[q], k0[q], lane); }
    }
}
__device__ __forceinline__ void conv_mats(const float* W, int nmat, int K, int Nsrc, int Nc, bf16* WT, bool gu, int gw, int NGW, int lane) {
    conv_range(W, K, Nsrc, Nc, WT, gu, gw, nmat * (Nc / 32) * (K / 64), NGW, lane);
}
constexpr int CONV_TOTAL = 24576, CONV_X = 4096;
__device__ __forceinline__ void conv_fp8(const float* W, unsigned char* WT, int N, int it, bool gu, float mul, int lane, int Nsrc = 0, int K = D) {
    const int nblk = N >> 5, per = nblk * (K >> 7), mat = it / per, r = it % per, k0 = (r / nblk) << 7, n0 = (r % nblk) << 5;
    const int drow0 = gu ? (256 * ((n0 & 1023) >> 7) + 128 * (n0 >> 10) + (n0 & 127)) : n0;
    const int Ns = Nsrc ? Nsrc : N;
    const float* p = W + (size_t)mat * K * Ns + (size_t)(k0 + 16 * (lane >> 3)) * Ns + n0 + 4 * (lane & 7);
    unsigned char* q = WT + (size_t)mat * N * K + (size_t)(drow0 + 4 * (lane & 7)) * K + k0 + 16 * (lane >> 3);
    f32x4 v[16];
#pragma unroll
    for (int i = 0; i < 16; ++i) v[i] = __builtin_nontemporal_load((const f32x4*)(p + (size_t)i * Ns)) * mul;
#pragma unroll
    for (int e = 0; e < 4; ++e) { i32x4 o;
#pragma unroll
        for (int w = 0; w < 4; ++w) { int x = 0; x = __builtin_amdgcn_cvt_pk_fp8_f32(v[4 * w][e], v[4 * w + 1][e], x, false); x = __builtin_amdgcn_cvt_pk_fp8_f32(v[4 * w + 2][e], v[4 * w + 3][e], x, true); o[w] = x; }
        __builtin_nontemporal_store(o, (i32x4*)(q + (size_t)e * K)); }
}
__device__ __forceinline__ void conv_unified(const float* gu, const float* dn, bf16* gut, bf16* dnt, int u0, int u1, int lane) {
    for (int u = u0; u < u1; ++u) { const int q3 = u / 3, r3 = u - 3 * q3;
        if (r3 < 2) conv_fp8(gu, (unsigned char*)gut, 2048, q3 * 2 + r3, true, (float)(1 << FP8_GU_SHIFT), lane);
        else conv_fp8(dn, (unsigned char*)dnt, D, q3, false, (float)(1 << FP8_DN_SHIFT), lane); }
}
__device__ __forceinline__ void conv_wg_range(const float* gu, const float* dn, bf16* gut, bf16* dnt, int w0, int w1, int wave, int lane) {
    const int len = w1 - w0; if (len <= 0) return; const int per = (len + NWAVES - 1) / NWAVES; const int a0 = w0 + wave * per, a1 = (a0 + per < w1) ? a0 + per : w1;
    if (a0 < a1) conv_unified(gu, dn, gut, dnt, a0, a1, lane);
}
__device__ __forceinline__ void conv_static(const float* gu, const float* dn, bf16* gut, bf16* dnt, gu32* cur, int x, int bx, int wave, int lane) {
    if (x > 0) { int c0 = (int)__hip_atomic_load((unsigned*)cur, __ATOMIC_RELAXED, __HIP_MEMORY_SCOPE_AGENT); c0 = c0 < x ? c0 : x; const int lw = (x - c0 + 255) >> 8;
        const int l0 = c0 + bx * lw, l1 = (l0 + lw < x) ? l0 + lw : x; conv_wg_range(gu, dn, gut, dnt, l0, l1, wave, lane); }
    const int ds = (CONV_TOTAL - x) >> 8; conv_wg_range(gu, dn, gut, dnt, x + bx * ds, x + (bx + 1) * ds, wave, lane);
}
__device__ __forceinline__ void conv_grab(const float* gu, const float* dn, bf16* gut, bf16* dnt, gu32* cur, int n, int lane) {
    unsigned base = 0; if (lane == 0) base = __hip_atomic_fetch_add((unsigned*)cur, (unsigned)n, __ATOMIC_RELAXED, __HIP_MEMORY_SCOPE_AGENT);
    base = __builtin_amdgcn_readfirstlane(base); if (base >= (unsigned)CONV_X) return;
    conv_unified(gu, dn, gut, dnt, (int)base, ((int)base + n < CONV_X) ? (int)base + n : CONV_X, lane);
}
#define MOE_GU(l)  (IN_(19) + (size_t)(l) * NE * D * 2048)
#define MOE_DN(l)  (IN_(21) + (size_t)(l) * NE * D * D)
#define MOE_GUT(l) ((bf16*)((unsigned char*)(WSP + WS_GU) + (size_t)(l) * NE * 2048 * D))
#define MOE_DNT(l) ((bf16*)((unsigned char*)(WSP + WS_DN) + (size_t)(l) * NE * D * D))
#define CONV_CUR(l) (CTL + CW_CV + (l) * 64)

__device__ __forceinline__ int t5_bucket(int n) {
    if (n < 16) return n;
    const float v = (logf((float)n / 16.0f) / 2.0794415416798357f) * 16.0f;
    const int large = 16 + (int)v;
    return large < 31 ? large : 31;
}

struct Args { const float* in[23]; float* out; unsigned char* ws; int ph_lo, ph_hi; };

typedef __attribute__((address_space(4))) const Args CArgs;
__device__ __forceinline__ CArgs* opaque_args() { CArgs* p = (CArgs*)__builtin_amdgcn_kernarg_segment_ptr(); asm volatile("" : "+s"(p)); return p; }
#define IN_(i)  (ap->in[i])
#define WSP     ((unsigned char*)ap->ws)
#define Hf      ((float*)ap->out)
#define HB      ((bf16*)(WSP + WS_HB))
#define UB      ((bf16*)(WSP + WS_U))
#define HB8     ((unsigned char*)(WSP + WS_U + 32 * MiB))
#define BIG1    ((bf16*)(WSP + WS_BIG1))
#define BIG2    ((bf16*)(WSP + WS_BIG2))
#define BIG3    ((float*)(WSP + WS_BIG3))
#define ACT     ((bf16*)(WSP + WS_ACT))
#define YS      ((bf16*)(WSP + WS_YS))
#define TOK     ((int*)(WSP + WS_TOK))
#define SELE    ((int*)(WSP + WS_SELE))
#define SELP    ((int*)(WSP + WS_SELP))
#define SELG    ((float*)(WSP + WS_SELG))
#define KMEAN   ((float*)(WSP + WS_KMEAN))
#define STATS   ((float*)(WSP + WS_STATS))
#define WRH     ((bf16*)(WSP + WS_WRT))
#define WRL     ((bf16*)(WSP + WS_WRT + 256 * 1024))
#define W16T    ((float*)(WSP + WS_W16T))
#define GKL     ((float*)(WSP + WS_GKL))
#define CTL     ((gu32*)(WSP + WS_CTL))

#define PH_BEGIN if (lo <= pid && pid < hi) for (int rep_ = 0; rep_ < ((((unsigned long long)PROBE_MASK >> pid) & 1ull) ? 2 : 1); ++rep_) { const int tid = opaque_tid(), lane = tid & 63, wave = __builtin_amdgcn_readfirstlane(tid >> 6), gw = bx * NWAVES + wave, NGW = G * NWAVES; CArgs* ap = opaque_args(); (void)lane; (void)gw; (void)NGW; (void)ap;
#define cursor  (CTL + CW_CNT + layer * 64)
#define OB      BIG3
#define LOGA    (BIG3 + (size_t)T * 1024)
#define GQE     ((bf16*)(BIG3 + (size_t)T * 1536))
#define GDEC    (BIG3 + (size_t)T * 1536 + (size_t)T * 256)
#define PH_END } if (lo <= pid && pid + 1 < hi) xcd_barrier_work(bar.bar, bar.x, bar.st, (unsigned)(pid + 1), opaque_args()); ++pid;


constexpr unsigned long long LOCAL_SEAMS = (1ull << 6) | (1ull << 13) | (1ull << 22) | (1ull << 29) | (1ull << 2) | (1ull << 3) | (1ull << 4) | (1ull << 8) | (1ull << 9) | (1ull << 10) | (1ull << 11) | (1ull << 15) | (1ull << 16) | (1ull << 17) | (1ull << 18) | (1ull << 19) | (1ull << 20)
                                         | (1ull << 24) | (1ull << 25) | (1ull << 26) | (1ull << 27);
constexpr int CW_WQ = 14336;
constexpr int WQ_PER_LAYER = CONV_TOTAL / 8;
__device__ __forceinline__ bool wq_grab_convert(CArgs* ap, unsigned x, int lane, unsigned& base) {
    unsigned b0 = 0; if (lane == 0) b0 = __hip_atomic_fetch_add((unsigned*)(CTL + CW_WQ + 64 * x), 2u, __ATOMIC_RELAXED, __HIP_MEMORY_SCOPE_AGENT);
    base = (unsigned)__builtin_amdgcn_readfirstlane((int)b0);
    if (base >= (unsigned)(NLAYER * WQ_PER_LAYER)) return false;
    const int wl = (int)base / WQ_PER_LAYER, u = (int)x * WQ_PER_LAYER + (int)base % WQ_PER_LAYER;
    conv_unified(MOE_GU(wl), MOE_DN(wl), MOE_GUT(wl), MOE_DNT(wl), u, u + 2, lane);
    return true;
}
__device__ __forceinline__ void wq_drain(CArgs* ap, int wl, int lane) {
    const unsigned x = xb_xcc_id() & 7u;
    for (;;) { unsigned base; if (!wq_grab_convert(ap, x, lane, base)) break; if (base >= (unsigned)((wl + 1) * WQ_PER_LAYER)) break; }
}
__device__ __forceinline__ void xcd_barrier_work(unsigned* bbar, unsigned bx_, volatile LAS unsigned* bst, unsigned seq, CArgs* ap) {
    XcdBarrier b; b.bar = bbar; b.x = bx_; b.st = bst;
    asm volatile("s_waitcnt vmcnt(0)" ::: "memory");
    __syncthreads();
    const int tid = threadIdx.x, lane = tid & 63, wave = __builtin_amdgcn_readfirstlane(tid >> 6);
    if (tid == 0) {
        unsigned* bar = b.bar;
        __builtin_amdgcn_s_waitcnt(0);
        unsigned nloc = b.st[0], nx = b.st[1];
        if (nloc == 0u) { xcd_barrier_complete(bar, b.x, nloc, nx); b.st[0] = nloc; b.st[1] = nx; }
        const unsigned old = xb_add(&bar[XB_XSUB(b.x)], 1u);
        const unsigned gen = old / nloc;
        const bool leader = (old + 1u == (gen + 1u) * nloc);
        bst[3] = seq * 4u + (leader ? 1u : 2u);
        const bool local_ = ((LOCAL_SEAMS >> seq) & 1ull) != 0ull && bst[8] == 1u;
        if (leader) {
            if (!local_) {
                __builtin_amdgcn_fence(__ATOMIC_RELEASE, "agent");
                asm volatile("s_waitcnt vmcnt(0)" ::: "memory");
                const unsigned og = xb_add(&bar[XB_TOP], 1u);
                const unsigned tg = og / nx;
                if (og + 1u == (tg + 1u) * nx) xb_add(&bar[XB_TOPGEN], 1u);
                else XB_SPIN(xb_ld(&bar[XB_TOPGEN]) == tg, bar);
            }
            __builtin_amdgcn_fence(__ATOMIC_ACQUIRE, "agent");
            xb_add(&bar[XB_XGEN(b.x)], 1u);
            asm volatile("s_waitcnt vmcnt(0)" ::: "memory");
        } else {
            XB_SPIN(xb_ld(&bar[XB_XGEN(b.x)]) == gen, bar);
            __builtin_amdgcn_fence(__ATOMIC_ACQUIRE, "agent");
            asm volatile("s_waitcnt vmcnt(0)" ::: "memory");
        }
        if (seq == 1u) bst[8] = (xb_ld(&bar[XB_MIS]) == 0u) ? 1u : 0u;
        bst[2] = seq;
    } else if (wave != 0) {
        unsigned r = 0, sp = 0;
        while ((((r = bst[3])) >> 2) != seq) { __builtin_amdgcn_s_sleep(1); if (++sp > (1u << 22)) break; }
        if ((r & 3u) == 2u) {
            const unsigned x = xb_xcc_id() & 7u; sp = 0;
            while (bst[2] != seq) {
                if (bst[6] == 0u) { unsigned base; if (!wq_grab_convert(ap, x, lane, base)) bst[6] = 1u; }
                else { __builtin_amdgcn_s_sleep(8); if (++sp > (1u << 22)) break; }
            }
        }
    }
    __syncthreads();
}

__device__ __forceinline__ void glds16(const void* gsrc, unsigned lds_dst) { unsigned keep;
    asm volatile("s_mov_b32 %0, m0\n\ts_mov_b32 m0, %2\n\ts_nop 0\n\tglobal_load_lds_dwordx4 %1, off\n\ts_mov_b32 m0, %0" : "=&s"(keep) : "v"(gsrc), "s"(lds_dst) : "memory"); }
#define LDS_ADDR(p) ((unsigned)__builtin_amdgcn_readfirstlane((int)(unsigned)(size_t)(p)))
typedef float f32x16 __attribute__((ext_vector_type(16)));
typedef short s16x4 __attribute__((ext_vector_type(4)));
typedef short v4i16_t __attribute__((ext_vector_type(4)));
typedef __bf16 bf16x2_t __attribute__((ext_vector_type(2)));
__device__ __forceinline__ unsigned pk_bf16(float lo, float hi) { f32x2 v = {lo, hi}; bf16x2_t b = __builtin_convertvector(v, bf16x2_t); return __builtin_bit_cast(unsigned, b); }
__device__ __forceinline__ unsigned off_b(unsigned row, unsigned ch) { return 256u * row + 16u * (ch ^ (((row & 3u) << 2) | ((row >> 2) & 3u))); }
__device__ __forceinline__ s16x4 lds_tr(LAS unsigned char* p) { return __builtin_bit_cast(s16x4, __builtin_amdgcn_ds_read_tr16_b64_v4i16((LAS v4i16_t*)p)); }

__device__ __forceinline__ void attn_phase(LAS unsigned char* lds, const bf16* QKV, bf16* O, const float* relb, const float* KP, const int G, const int bx, const int tid) {
    constexpr int KB0 = 0, VB0 = 16384, KM_OFF = 114688, GT_OFF = 118784, SEL_OFF = 126976, TAB_OFF = 128000;
    constexpr float C1 = 0.08838834764831845f * 1.4426950408889634f, LOG2E = 1.4426950408889634f;
    const int lane = tid & 63, wave = __builtin_amdgcn_readfirstlane(tid >> 6), r32 = lane & 31, h2 = lane >> 5;
    LAS float* KM = (LAS float*)(lds + KM_OFF); LAS float* GT = (LAS float*)(lds + GT_OFF); LAS int* SELB = (LAS int*)(lds + SEL_OFF); LAS float* TAB = (LAS float*)(lds + TAB_OFF);
    const int vcu = (G % 8 == 0) ? (bx % 8) * (G / 8) + bx / 8 : bx;
    for (int pp_ = vcu; pp_ < 256 * ATT_REP; pp_ += G) { const int p = pp_ & 255;
    for (int uu = 0; uu < 2; ++uu) {
        const int bh = p >> 2, ol = p & 3, o = (uu == 0) ? (7 - ol) : ol, b = bh >> 3, h = bh & 7;
        const size_t tok0 = (size_t)b * SEQ;
        if (tid < 128) TAB[tid] = relb[t5_bucket(tid) * AH + h] * LOG2E;
        if (o > 3) {
            int tz = tid; asm volatile("" : "+v"(tz));
            for (int i = tz; i < o * 128; i += NTHR) { const int n = i >> 7, d = i & 127; const float* kp = KP + ((size_t)(b * 8 + n) * 2) * 1024 + h * 128 + d;
                KM[i] = (kp[0] + kp[1024]) * (1.0f / 256.0f); }
        }
        __syncthreads();
        if (o > 3) {
            const int qi = tid & 255, part = tid >> 8;
            const bf16* qrow = QKV + (tok0 + o * 256 + qi) * 3072 + h * 128;
            float ga[4] = {0.f, 0.f, 0.f, 0.f};
            u32x4 qa[16];
#pragma unroll
            for (int c = 0; c < 16; ++c) qa[c] = *(const u32x4*)(qrow + c * 8);
#pragma unroll
            for (int c = 0; c < 16; ++c) { const u32x4 qv = qa[c];
                const float q8[8] = {__uint_as_float(qv.x << 16), __uint_as_float(qv.x & 0xffff0000u), __uint_as_float(qv.y << 16), __uint_as_float(qv.y & 0xffff0000u),
                                     __uint_as_float(qv.z << 16), __uint_as_float(qv.z & 0xffff0000u), __uint_as_float(qv.w << 16), __uint_as_float(qv.w & 0xffff0000u)};
#pragma unroll
                for (int k = 0; k < 4; ++k) { const int n = part + 2 * k; if (n < o) { const f32x4 k0 = *(const LAS f32x4*)(KM + n * 128 + c * 8), k1 = *(const LAS f32x4*)(KM + n * 128 + c * 8 + 4);
                    ga[k] += (q8[0] * k0[0] + q8[1] * k0[1]) + (q8[2] * k0[2] + q8[3] * k0[3]) + (q8[4] * k1[0] + q8[5] * k1[1]) + (q8[6] * k1[2] + q8[7] * k1[3]); } } }
#pragma unroll
            for (int k = 0; k < 4; ++k) { const int n = part + 2 * k; if (n < o) GT[qi * 8 + n] = ga[k]; }
            __syncthreads();
            if (tid < 256) { unsigned sel = 0u;
#pragma unroll
                for (int r = 0; r < 3; ++r) { float best = -INFINITY; int bi = -1;
                    for (int n = 0; n < o; ++n) { const float gv = GT[tid * 8 + n]; if (!((sel >> n) & 1u) && gv > best) { best = gv; bi = n; } }
                    if (bi >= 0) sel |= 1u << bi; }
                SELB[tid] = (int)sel; }
        } else { if (tid < 256) SELB[tid] = (1 << o) - 1; }
        __syncthreads();
        const int qloc = 32 * wave + r32, qpos = o * 256 + qloc;
        bf16x8 qf[8];
        { const bf16* qrow = QKV + (tok0 + qpos) * 3072 + h * 128 + 8 * h2;
#pragma unroll
          for (int ks = 0; ks < 8; ++ks) qf[ks] = *(const bf16x8*)(qrow + 16 * ks); }
        const unsigned selb = (unsigned)SELB[qloc];
        float m = -1e30f, l = 0.f;
        f32x16 oacc[4];
#pragma unroll
        for (int dt = 0; dt < 4; ++dt)
#pragma unroll
            for (int i = 0; i < 16; ++i) oacc[dt][i] = 0.f;
        const int ntiles = 4 * (o + 1);
        unsigned goff[2];
#pragma unroll
        for (int jj = 0; jj < 2; ++jj) { const unsigned row = 8 * wave + 4 * jj + (lane >> 4), cl = lane & 15, ch = cl ^ (((row & 3u) << 2) | ((row >> 2) & 3u)); goff[jj] = row * 6144u + ch * 16u; }
#define ATT_STAGE(bufo, nn, tt) do { const char* kp_ = (const char*)(QKV + (tok0 + (nn) * 256 + (tt) * 64) * 3072 + 1024 + h * 128); \
            _Pragma("unroll") for (int jj = 0; jj < 2; ++jj) { \
                glds16(kp_ + goff[jj], LDS_ADDR(lds + (bufo) + KB0 + (8 * wave + 4 * jj) * 256)); \
                glds16(kp_ + 2048 + goff[jj], LDS_ADDR(lds + (bufo) + VB0 + (8 * wave + 4 * jj) * 256)); } } while (0)
        ATT_STAGE(0, o, 0);
        ATT_STAGE(32768, o, 1);
        asm volatile("s_waitcnt vmcnt(4)" ::: "memory"); __builtin_amdgcn_s_barrier(); asm volatile("" ::: "memory");
        int slot = 0;
        for (int it = 0; it < ntiles; ++it) {
            const int n = (it < 4) ? o : (o - 1 - ((it - 4) >> 2)), t = it & 3;
            const int buf = slot * 32768;
            if (it + 2 < ntiles) { const int n2 = (it + 2 < 4) ? o : (o - 1 - ((it + 2 - 4) >> 2)), t2 = (it + 2) & 3; const int s2 = (slot >= 1) ? slot - 1 : 2; ATT_STAGE(s2 * 32768, n2, t2); }
            const bool own = (n == o);
            const bool active = !own || (64 * t <= 32 * wave + 31);
            if (active) {
                f32x16 S[2];
#pragma unroll
                for (int i = 0; i < 16; ++i) { S[0][i] = 0.f; S[1][i] = 0.f; }
#pragma unroll
                for (int ks = 0; ks < 8; ++ks) {
                    const bf16x8 k0 = *(const LAS bf16x8*)(lds + buf + KB0 + off_b(r32, 2 * ks + h2)), k1 = *(const LAS bf16x8*)(lds + buf + KB0 + off_b(32 + r32, 2 * ks + h2));
                    S[0] = __builtin_amdgcn_mfma_f32_32x32x16_bf16(k0, qf[ks], S[0], 0, 0, 0);
                    S[1] = __builtin_amdgcn_mfma_f32_32x32x16_bf16(k1, qf[ks], S[1], 0, 0, 0);
                }
                const int dq = qpos - (n * 256 + 64 * t) - 4 * h2;
                const bool lanesel = own || ((selb >> n) & 1u);
                const bool neartab = own || (32 * wave - 64 * t + 256 * (o - n) - 63 < 113);
                float mx = -INFINITY;
                if (neartab) {
#pragma unroll
                    for (int kt = 0; kt < 2; ++kt)
#pragma unroll
                        for (int i = 0; i < 16; ++i) { const int dist = dq - (32 * kt + (i & 3) + 8 * (i >> 2));
                            const float bias = TAB[dist < 0 ? 0 : (dist > 127 ? 127 : dist)];
                            const float sv = (lanesel && dist >= 0) ? (S[kt][i] * C1 + bias) : -INFINITY; S[kt][i] = sv; mx = fmaxf(mx, sv); }
                } else {
                    const float bias = TAB[127];
#pragma unroll
                    for (int kt = 0; kt < 2; ++kt)
#pragma unroll
                        for (int i = 0; i < 16; ++i) { const float sv = lanesel ? (S[kt][i] * C1 + bias) : -INFINITY; S[kt][i] = sv; mx = fmaxf(mx, sv); }
                }
                mx = fmaxf(mx, __shfl_xor(mx, 32));
                const float mn = fmaxf(m, mx), alpha = __builtin_amdgcn_exp2f(m - mn);
                m = mn;
                float ps = 0.f;
#pragma unroll
                for (int kt = 0; kt < 2; ++kt)
#pragma unroll
                    for (int i = 0; i < 16; ++i) { const float pv = __builtin_amdgcn_exp2f(S[kt][i] - mn); S[kt][i] = pv; ps += pv; }
                l = l * alpha + ps;
                if (__builtin_amdgcn_ballot_w64(alpha != 1.0f) != 0ull) {
#pragma unroll
                    for (int dt = 0; dt < 4; ++dt)
#pragma unroll
                        for (int i = 0; i < 16; ++i) oacc[dt][i] *= alpha; }
                bf16x8 pf[2][2];
#pragma unroll
                for (int kt = 0; kt < 2; ++kt)
#pragma unroll
                    for (int s2 = 0; s2 < 2; ++s2) { u32x4 w; w.x = pk_bf16(S[kt][8 * s2 + 0], S[kt][8 * s2 + 1]); w.y = pk_bf16(S[kt][8 * s2 + 2], S[kt][8 * s2 + 3]);
                        w.z = pk_bf16(S[kt][8 * s2 + 4], S[kt][8 * s2 + 5]); w.w = pk_bf16(S[kt][8 * s2 + 6], S[kt][8 * s2 + 7]); pf[kt][s2] = __builtin_bit_cast(bf16x8, w); }
                const unsigned blk = (lane >> 4) & 1, tq = (lane & 15) >> 2, tp = lane & 3;
#pragma unroll
                for (int kt = 0; kt < 2; ++kt)
#pragma unroll
                    for (int s2 = 0; s2 < 2; ++s2)
#pragma unroll
                        for (int dt = 0; dt < 4; ++dt) {
                            const unsigned row0 = 32 * kt + 16 * s2 + 4 * h2 + tq;
                            const s16x4 lo = lds_tr(lds + buf + VB0 + off_b(row0, 4 * dt + 2 * blk + (tp >> 1)) + 8 * (tp & 1));
                            const s16x4 hi = lds_tr(lds + buf + VB0 + off_b(row0 + 8, 4 * dt + 2 * blk + (tp >> 1)) + 8 * (tp & 1));
                            const bf16x8 vf = __builtin_shufflevector(lo, hi, 0, 1, 2, 3, 4, 5, 6, 7);
                            oacc[dt] = __builtin_amdgcn_mfma_f32_32x32x16_bf16(vf, pf[kt][s2], oacc[dt], 0, 0, 0);
                        }
            }
            if (it + 2 < ntiles) asm volatile("s_waitcnt vmcnt(4) lgkmcnt(0)" ::: "memory"); else asm volatile("s_waitcnt vmcnt(0) lgkmcnt(0)" ::: "memory");
            __builtin_amdgcn_s_barrier(); asm volatile("" ::: "memory");
            slot = (slot == 2) ? 0 : slot + 1;
        }
        l += __shfl_xor(l, 32);
        const float inv = 16.0f / l;
        unsigned char* orow = (unsigned char*)O + (tok0 + qpos) * 1024 + h * 128 + 4 * h2;
#pragma unroll
        for (int dt = 0; dt < 4; ++dt)
#pragma unroll
            for (int g4 = 0; g4 < 4; ++g4) { int w8 = 0; w8 = __builtin_amdgcn_cvt_pk_fp8_f32(oacc[dt][4 * g4] * inv, oacc[dt][4 * g4 + 1] * inv, w8, false); w8 = __builtin_amdgcn_cvt_pk_fp8_f32(oacc[dt][4 * g4 + 2] * inv, oacc[dt][4 * g4 + 3] * inv, w8, true);
                *(int*)(orow + 32 * dt + 8 * g4) = w8; }
        __syncthreads();
    }
    }
#undef ATT_STAGE
}


__device__ __forceinline__ void gla_chunk_phase(LAS unsigned char* lds, const bf16* P, const float* GKL_, const float* wup, const float* bgk, bf16* QEg, float* OB_, bf16* SLOC, float* DEC, const int G, const int bx, const int tid) {
    constexpr int QE_O = 0, KE_O = 16384, KD_O = 32768, V_O = 49152, SEG_O = 81920;
    const int lane = tid & 63, wave = __builtin_amdgcn_readfirstlane(tid >> 6), r32 = lane & 31, h2 = lane >> 5;
    const unsigned blk = (lane >> 4) & 1, tq = (lane & 15) >> 2, tp = lane & 3;
    LAS float* SEG = (LAS float*)(lds + SEG_O);
    const int vcu = (G % 8 == 0) ? (bx % 8) * (G / 8) + bx / 8 : bx;
    const int ustep = (G == 256) ? 32 : G, ubase = (G == 256) ? 128 * (bx & 7) + (bx >> 3) : vcu, uend = (G == 256) ? ubase + 128 : BATCH * 32 * CH;
    for (int u = ubase; u < uend; u += ustep) {
        const int hd = u & 3, c = (u >> 2) & 31, b = u >> 7;
        const size_t tok0 = (size_t)b * SEQ + c * 64;
#pragma unroll
        for (int jj = 0; jj < 4; ++jj) { const int pp = 4 * wave + jj, sub = pp >> 4; const unsigned row = 4 * (pp & 15) + (lane >> 4), cl = lane & 15, ch = cl ^ (((row & 3u) << 2) | ((row >> 2) & 3u));
            glds16(P + (tok0 + row) * 3072 + 1024 + hd * 256 + sub * 128 + ch * 8, LDS_ADDR(lds + V_O + sub * 16384 + 4 * (pp & 15) * 256)); }
        const int k2 = lane, seg = wave;
        f32x2 cum[8]; unsigned qp[8], kp[8];
        f32x2 wu[16]; const f32x2 bg = *(const f32x2*)(bgk + hd * 128 + 2 * k2);
#pragma unroll
        for (int t16 = 0; t16 < 16; ++t16) wu[t16] = *(const f32x2*)(wup + t16 * CKEY + hd * 128 + 2 * k2);
        LAS float* GK = (LAS float*)(lds + SEG_O + 4096);
        if (tid < 256) *(LAS f32x4*)(GK + 4 * tid) = *(const f32x4*)(GKL_ + tok0 * 16 + 4 * tid);
#pragma unroll
        for (int i = 0; i < 8; ++i) { const size_t row = tok0 + seg * 8 + i; qp[i] = *(const unsigned*)(P + row * 3072 + hd * 128 + 2 * k2); kp[i] = *(const unsigned*)(P + row * 3072 + 512 + hd * 128 + 2 * k2); }
        __syncthreads();
        { float c0 = 0.f, c1 = 0.f;
#pragma unroll
          for (int i = 0; i < 8; ++i) { f32x2 la = bg;
#pragma unroll
              for (int t4 = 0; t4 < 4; ++t4) { const f32x4 g4 = *(const LAS f32x4*)(GK + (seg * 8 + i) * 16 + 4 * t4);
#pragma unroll
                  for (int e = 0; e < 4; ++e) la += wu[4 * t4 + e] * g4[e]; }
              la.x = (fminf(la.x, 0.f) - __logf(1.0f + __expf(-fabsf(la.x)))) * (1.0f / 16.0f); la.y = (fminf(la.y, 0.f) - __logf(1.0f + __expf(-fabsf(la.y)))) * (1.0f / 16.0f);
              c0 += la.x; c1 += la.y; cum[i] = (f32x2){c0, c1}; }
          *(LAS f32x2*)(SEG + seg * 128 + 2 * k2) = (f32x2){c0, c1}; }
        __syncthreads();
        f32x2 pre = {0.f, 0.f}, tot = {0.f, 0.f};
#pragma unroll
        for (int s2 = 0; s2 < 8; ++s2) { const f32x2 v = *(const LAS f32x2*)(SEG + s2 * 128 + 2 * k2); tot += v; if (s2 < seg) pre += v; }
#pragma unroll
        for (int i = 0; i < 8; ++i) { const int row = seg * 8 + i; const f32x2 bb = pre + cum[i];
            const float q0 = __uint_as_float(qp[i] << 16) * 0.08838834764831845f, q1 = __uint_as_float(qp[i] & 0xffff0000u) * 0.08838834764831845f;
            const float k0 = __uint_as_float(kp[i] << 16), k1 = __uint_as_float(kp[i] & 0xffff0000u);
            const float e0 = __expf(bb.x), e1 = __expf(bb.y);
            const unsigned qe = pk_bf16(q0 * e0, q1 * e1), ke = pk_bf16(k0 * __expf(-bb.x), k1 * __expf(-bb.y)), kd = pk_bf16(k0 * __expf(tot.x - bb.x), k1 * __expf(tot.y - bb.y));
            const unsigned lo = off_b(row, k2 >> 2) + (k2 & 3) * 4;
            *(LAS unsigned*)(lds + QE_O + lo) = qe; *(LAS unsigned*)(lds + KE_O + lo) = ke; *(LAS unsigned*)(lds + KD_O + lo) = kd;
            *(unsigned*)(QEg + (tok0 + row) * CKEY + hd * 128 + 2 * k2) = qe; }
        if (seg == 0) *(f32x2*)(DEC + ((size_t)(b * CH + hd) * 32 + c) * 128 + 2 * k2) = (f32x2){__expf(tot.x), __expf(tot.y)};
        VM_WAIT(); __syncthreads();
        f32x16 X00, X01, X11;
#pragma unroll
        for (int i = 0; i < 16; ++i) { X00[i] = 0.f; X01[i] = 0.f; X11[i] = 0.f; }
#pragma unroll
        for (int ks = 0; ks < 8; ++ks) {
            const bf16x8 a0 = *(const LAS bf16x8*)(lds + KE_O + off_b(r32, 2 * ks + h2)), a1 = *(const LAS bf16x8*)(lds + KE_O + off_b(32 + r32, 2 * ks + h2));
            const bf16x8 b0 = *(const LAS bf16x8*)(lds + QE_O + off_b(r32, 2 * ks + h2)), b1 = *(const LAS bf16x8*)(lds + QE_O + off_b(32 + r32, 2 * ks + h2));
            X00 = __builtin_amdgcn_mfma_f32_32x32x16_bf16(a0, b0, X00, 0, 0, 0);
            X01 = __builtin_amdgcn_mfma_f32_32x32x16_bf16(a0, b1, X01, 0, 0, 0);
            X11 = __builtin_amdgcn_mfma_f32_32x32x16_bf16(a1, b1, X11, 0, 0, 0);
        }
#pragma unroll
        for (int i = 0; i < 16; ++i) { const int jl = (i & 3) + 8 * (i >> 2) + 4 * h2; if (jl > r32) { X00[i] = 0.f; X11[i] = 0.f; } }
        bf16x8 p00[2], p01[2], p11[2];
#pragma unroll
        for (int s2 = 0; s2 < 2; ++s2) { u32x4 w;
            w.x = pk_bf16(X00[8 * s2], X00[8 * s2 + 1]); w.y = pk_bf16(X00[8 * s2 + 2], X00[8 * s2 + 3]); w.z = pk_bf16(X00[8 * s2 + 4], X00[8 * s2 + 5]); w.w = pk_bf16(X00[8 * s2 + 6], X00[8 * s2 + 7]); p00[s2] = __builtin_bit_cast(bf16x8, w);
            w.x = pk_bf16(X01[8 * s2], X01[8 * s2 + 1]); w.y = pk_bf16(X01[8 * s2 + 2], X01[8 * s2 + 3]); w.z = pk_bf16(X01[8 * s2 + 4], X01[8 * s2 + 5]); w.w = pk_bf16(X01[8 * s2 + 6], X01[8 * s2 + 7]); p01[s2] = __builtin_bit_cast(bf16x8, w);
            w.x = pk_bf16(X11[8 * s2], X11[8 * s2 + 1]); w.y = pk_bf16(X11[8 * s2 + 2], X11[8 * s2 + 3]); w.z = pk_bf16(X11[8 * s2 + 4], X11[8 * s2 + 5]); w.w = pk_bf16(X11[8 * s2 + 6], X11[8 * s2 + 7]); p11[s2] = __builtin_bit_cast(bf16x8, w); }
        const int sv = wave >> 2, dt = wave & 3;
        LAS unsigned char* Vimg = lds + V_O + sv * 16384;
        f32x16 O0, O1;
#pragma unroll
        for (int i = 0; i < 16; ++i) { O0[i] = 0.f; O1[i] = 0.f; }
#pragma unroll
        for (int jt = 0; jt < 2; ++jt)
#pragma unroll
            for (int s2 = 0; s2 < 2; ++s2) {
                const unsigned row0 = 32 * jt + 16 * s2 + 4 * h2 + tq;
                const s16x4 lo = lds_tr(Vimg + off_b(row0, 4 * dt + 2 * blk + (tp >> 1)) + 8 * (tp & 1)), hi = lds_tr(Vimg + off_b(row0 + 8, 4 * dt + 2 * blk + (tp >> 1)) + 8 * (tp & 1));
                const bf16x8 vf = __builtin_shufflevector(lo, hi, 0, 1, 2, 3, 4, 5, 6, 7);
                if (jt == 0) { O0 = __builtin_amdgcn_mfma_f32_32x32x16_bf16(vf, p00[s2], O0, 0, 0, 0); O1 = __builtin_amdgcn_mfma_f32_32x32x16_bf16(vf, p01[s2], O1, 0, 0, 0); }
                else O1 = __builtin_amdgcn_mfma_f32_32x32x16_bf16(vf, p11[s2], O1, 0, 0, 0);
            }
        { bf16* ob = (bf16*)OB_ + (tok0 + r32) * 1024 + hd * 256 + 32 * wave + 4 * h2;
#pragma unroll
          for (int g4 = 0; g4 < 4; ++g4) { u32x2 w0, w1; w0.x = pk_bf16(O0[4 * g4], O0[4 * g4 + 1]); w0.y = pk_bf16(O0[4 * g4 + 2], O0[4 * g4 + 3]); w1.x = pk_bf16(O1[4 * g4], O1[4 * g4 + 1]); w1.y = pk_bf16(O1[4 * g4 + 2], O1[4 * g4 + 3]);
              *(u32x2*)(ob + 8 * g4) = w0; *(u32x2*)(ob + (size_t)32 * 1024 + 8 * g4) = w1; } }
        f32x16 Sa[4];
#pragma unroll
        for (int kt = 0; kt < 4; ++kt)
#pragma unroll
            for (int i = 0; i < 16; ++i) Sa[kt][i] = 0.f;
#pragma unroll
        for (int s4 = 0; s4 < 4; ++s4) {
            const unsigned rowb = 16 * s4 + 8 * h2 + tq;
            const s16x4 blo = lds_tr(Vimg + off_b(rowb, 4 * dt + 2 * blk + (tp >> 1)) + 8 * (tp & 1)), bhi = lds_tr(Vimg + off_b(rowb + 4, 4 * dt + 2 * blk + (tp >> 1)) + 8 * (tp & 1));
            const bf16x8 vb = __builtin_shufflevector(blo, bhi, 0, 1, 2, 3, 4, 5, 6, 7);
#pragma unroll
            for (int kt = 0; kt < 4; ++kt) {
                const s16x4 alo = lds_tr(lds + KD_O + off_b(rowb, 4 * kt + 2 * blk + (tp >> 1)) + 8 * (tp & 1)), ahi = lds_tr(lds + KD_O + off_b(rowb + 4, 4 * kt + 2 * blk + (tp >> 1)) + 8 * (tp & 1));
                const bf16x8 ka = __builtin_shufflevector(alo, ahi, 0, 1, 2, 3, 4, 5, 6, 7);
                Sa[kt] = __builtin_amdgcn_mfma_f32_32x32x16_bf16(ka, vb, Sa[kt], 0, 0, 0);
            }
        }
        { unsigned char* sp = (unsigned char*)SLOC + ((size_t)(b * CH + hd) * 32 + c) * (CDV * CDK) + (size_t)(32 * wave + r32) * CDK + 4 * h2;
#pragma unroll
          for (int kt = 0; kt < 4; ++kt)
#pragma unroll
              for (int g4 = 0; g4 < 4; ++g4) { int w8 = 0; w8 = __builtin_amdgcn_cvt_pk_fp8_f32(Sa[kt][4 * g4], Sa[kt][4 * g4 + 1], w8, false); w8 = __builtin_amdgcn_cvt_pk_fp8_f32(Sa[kt][4 * g4 + 2], Sa[kt][4 * g4 + 3], w8, true); *(int*)(sp + 32 * kt + 8 * g4) = w8; } }
        __syncthreads();
    }
}
struct ScanSet { bf16x8 qb[2]; u32x2 sl; u32x2 ob; };
__device__ __forceinline__ void gla_scan_phase(LAS unsigned char* lds, const bf16* QEg, float* OB_, const bf16* SLOC, const float* DEC, const int G, const int bx, const int tid) {
    const int lane = tid & 63, wave = __builtin_amdgcn_readfirstlane(tid >> 6), r32 = lane & 31, h2 = lane >> 5, tl = lane >> 3, vq = lane & 7;
    constexpr int DL_O = 65536;
    LAS float* DL = (LAS float*)(lds + DL_O);
    const int vcu = (G % 8 == 0) ? (bx % 8) * (G / 8) + bx / 8 : bx;
    for (int u = vcu; u < BATCH * CH * 8; u += G) {
        const int vs = u & 7, hd = (u >> 3) & 3, b = u >> 5;
        const size_t bhc = (size_t)(b * CH + hd) * 32;
        for (int i = tid; i < 32 * 128 / 4; i += NTHR) ((LAS f32x4*)DL)[i] = ((const f32x4*)(DEC + bhc * 128))[i];
        float st[8];
#pragma unroll
        for (int j2 = 0; j2 < 8; ++j2) st[j2] = 0.f;
        const bf16* qbase = QEg + ((size_t)b * SEQ + r32) * CKEY + hd * 128 + 16 * wave + 8 * h2;
        const unsigned char* sbase = (const unsigned char*)SLOC + bhc * (CDV * CDK) + (size_t)(32 * vs + r32) * CDK + 16 * wave + 8 * h2;
        bf16* obase = (bf16*)OB_ + ((size_t)b * SEQ + 8 * wave + tl) * 1024 + hd * 256 + 32 * vs + 4 * vq;
        const unsigned pw = (unsigned)(wave * 8192 + r32 * 128), psw = (unsigned)(r32 & 7);
        const int ro = (8 * wave + tl) & 31;
        const unsigned pr = (unsigned)((wave >> 2) * 4096 + ro * 128 + ((vq ^ (ro & 7)) * 16));
        const LAS float* dlp = DL + 16 * wave + 8 * h2;
#define SCAN_LOAD(S_, cc) do { S_.qb[0] = *(const bf16x8*)(qbase + (size_t)(cc) * 64 * CKEY); S_.qb[1] = *(const bf16x8*)(qbase + (size_t)(cc) * 64 * CKEY + 32 * CKEY); \
            S_.sl = *(const u32x2*)(sbase + (size_t)(cc) * (CDV * CDK)); S_.ob = *(const u32x2*)(obase + (size_t)(cc) * 64 * 1024); } while (0)
#define SCAN_STEP(S_, cc) do { \
            if ((cc) > 0) { u32x4 aw; aw.x = pk_bf16(st[0], st[1]); aw.y = pk_bf16(st[2], st[3]); aw.z = pk_bf16(st[4], st[5]); aw.w = pk_bf16(st[6], st[7]); const bf16x8 av = __builtin_bit_cast(bf16x8, aw); \
                f32x16 c0, c1; _Pragma("unroll") for (int i = 0; i < 16; ++i) { c0[i] = 0.f; c1[i] = 0.f; } \
                c0 = __builtin_amdgcn_mfma_f32_32x32x16_bf16(av, S_.qb[0], c0, 0, 0, 0); c1 = __builtin_amdgcn_mfma_f32_32x32x16_bf16(av, S_.qb[1], c1, 0, 0, 0); \
                _Pragma("unroll") for (int g = 0; g < 4; ++g) { const unsigned so = pw + (((unsigned)(2 * g + h2) ^ psw) << 4); \
                    *(LAS f32x4*)(lds + so) = (f32x4){c0[4 * g], c0[4 * g + 1], c0[4 * g + 2], c0[4 * g + 3]}; *(LAS f32x4*)(lds + so + 4096) = (f32x4){c1[4 * g], c1[4 * g + 1], c1[4 * g + 2], c1[4 * g + 3]}; } } \
            { const f32x2 p0 = __builtin_amdgcn_cvt_pk_f32_fp8((int)S_.sl.x, false), p1 = __builtin_amdgcn_cvt_pk_f32_fp8((int)S_.sl.x, true), p2 = __builtin_amdgcn_cvt_pk_f32_fp8((int)S_.sl.y, false), p3 = __builtin_amdgcn_cvt_pk_f32_fp8((int)S_.sl.y, true); \
              const f32x4 d0 = *(const LAS f32x4*)(dlp + (cc) * 128), d1 = *(const LAS f32x4*)(dlp + (cc) * 128 + 4); \
              st[0] = d0[0] * st[0] + p0.x; st[1] = d0[1] * st[1] + p0.y; st[2] = d0[2] * st[2] + p1.x; st[3] = d0[3] * st[3] + p1.y; \
              st[4] = d1[0] * st[4] + p2.x; st[5] = d1[1] * st[5] + p2.y; st[6] = d1[2] * st[6] + p3.x; st[7] = d1[3] * st[7] + p3.y; } \
            if ((cc) > 0) { LDS_WAIT(); __builtin_amdgcn_s_barrier(); asm volatile("" ::: "memory"); \
                f32x4 sm = *(const LAS f32x4*)(lds + pr); \
                _Pragma("unroll") for (int s2 = 1; s2 < 8; ++s2) sm += *(const LAS f32x4*)(lds + pr + s2 * 8192); \
                u32x2 ow; ow.x = pk_bf16(__uint_as_float(S_.ob.x << 16) + sm[0], __uint_as_float(S_.ob.x & 0xffff0000u) + sm[1]); ow.y = pk_bf16(__uint_as_float(S_.ob.y << 16) + sm[2], __uint_as_float(S_.ob.y & 0xffff0000u) + sm[3]); \
                *(u32x2*)(obase + (size_t)(cc) * 64 * 1024) = ow; \
                LDS_WAIT(); __builtin_amdgcn_s_barrier(); asm volatile("" ::: "memory"); } } while (0)
        ScanSet A, B, C, E;
        SCAN_LOAD(A, 0); SCAN_LOAD(B, 1); SCAN_LOAD(C, 2); SCAN_LOAD(E, 3);
        __syncthreads();
#pragma unroll 1
        for (int c = 0; c < 28; c += 4) {
            SCAN_STEP(A, c); SCAN_LOAD(A, c + 4);
            SCAN_STEP(B, c + 1); SCAN_LOAD(B, c + 5);
            SCAN_STEP(C, c + 2); SCAN_LOAD(C, c + 6);
            SCAN_STEP(E, c + 3); SCAN_LOAD(E, c + 7);
        }
        SCAN_STEP(A, 28); SCAN_STEP(B, 29); SCAN_STEP(C, 30); SCAN_STEP(E, 31);
#undef SCAN_LOAD
#undef SCAN_STEP
        __syncthreads();
    }
}

__device__ __forceinline__ void gmlp_mix_phase(LAS unsigned char* lds, const bf16* Z, const float* ST, const float* lng, const float* lnb, const float* wsp, const float* bsp, bf16* Y, const int G, const int bx, const int tid) {
    constexpr int VL_O = 0, W_O = 65536, RS_O = 98304;
    const int lane = tid & 63, wave = __builtin_amdgcn_readfirstlane(tid >> 6), r32 = lane & 31, h2 = lane >> 5;
    const unsigned blk = (lane >> 4) & 1, tq = (lane & 15) >> 2, tp = lane & 3;
    LAS f32x2* RS = (LAS f32x2*)(lds + RS_O);
    const int vcu = (G % 8 == 0) ? (bx % 8) * (G / 8) + bx / 8 : bx;
    int gprev = -1;
    u32x4 zv[8];
#define GM_ZLOAD(u_) do { const int g_ = (u_) & 7; const size_t t0_ = (size_t)((u_) >> 7) * SEQ + (((u_) >> 3) & 15) * 128; _Pragma("unroll") for (int i = 0; i < 8; ++i) zv[i] = *(const u32x4*)(Z + (t0_ + (tid >> 5) + 16 * i) * 4096 + 2048 + g_ * 256 + (tid & 31) * 8); } while (0)
    const int ustep = (G == 256) ? 32 : G, ubase = (G == 256) ? 128 * (bx & 7) + (bx >> 3) : vcu, uend = (G == 256) ? ubase + 128 : BATCH * 16 * BG;
    if (ubase < uend) GM_ZLOAD(ubase);
    for (int u = ubase; u < uend; u += ustep) {
        const int g = u & 7, cch = (u >> 3) & 15, b = u >> 7;
        const size_t tok0 = (size_t)b * SEQ + cch * 128;
        if (tid < 128) { float s = 0.f, q = 0.f; const f32x4* sp = (const f32x4*)(ST + (tok0 + tid) * 64);
#pragma unroll
            for (int i = 0; i < 16; ++i) { const f32x4 v = sp[i]; s += v[0] + v[2]; q += v[1] + v[3]; }
            const float mean = s * (1.0f / 2048.0f), var = fmaxf(q * (1.0f / 2048.0f) - mean * mean, 0.f); RS[tid] = (f32x2){mean, 1.0f / sqrtf(var + LN_EPS)}; }
        if (g != gprev) {
#pragma unroll
        for (int i = 0; i < 4; ++i) { const int id = tid + NTHR * i, t = id >> 4, ch = id & 15; const float* wp = wsp + ((size_t)g * 128 + t) * 128 + ch * 8; const f32x4 w0 = *(const f32x4*)wp, w1 = *(const f32x4*)(wp + 4);
            float w[8] = {w0[0], w0[1], w0[2], w0[3], w1[0], w1[1], w1[2], w1[3]};
#pragma unroll
            for (int e = 0; e < 8; ++e) if (ch * 8 + e > t) w[e] = 0.f;
            u32x4 o; o.x = pk_bf16(w[0], w[1]); o.y = pk_bf16(w[2], w[3]); o.z = pk_bf16(w[4], w[5]); o.w = pk_bf16(w[6], w[7]);
            *(LAS u32x4*)(lds + W_O + off_b(t, ch)) = o; }
        gprev = g; }
        __syncthreads();
        { const int ch32 = tid & 31; const f32x4 g0 = *(const f32x4*)(lng + g * 256 + ch32 * 8), g1 = *(const f32x4*)(lng + g * 256 + ch32 * 8 + 4), b0 = *(const f32x4*)(lnb + g * 256 + ch32 * 8), b1 = *(const f32x4*)(lnb + g * 256 + ch32 * 8 + 4);
#pragma unroll
          for (int i = 0; i < 8; ++i) { const int row = (tid >> 5) + 16 * i; const u32x4 zw = zv[i]; const f32x2 rs = RS[row];
              const float z[8] = {__uint_as_float(zw.x << 16), __uint_as_float(zw.x & 0xffff0000u), __uint_as_float(zw.y << 16), __uint_as_float(zw.y & 0xffff0000u),
                                  __uint_as_float(zw.z << 16), __uint_as_float(zw.z & 0xffff0000u), __uint_as_float(zw.w << 16), __uint_as_float(zw.w & 0xffff0000u)};
              u32x4 o; o.x = pk_bf16((z[0] - rs.x) * rs.y * g0[0] + b0[0], (z[1] - rs.x) * rs.y * g0[1] + b0[1]); o.y = pk_bf16((z[2] - rs.x) * rs.y * g0[2] + b0[2], (z[3] - rs.x) * rs.y * g0[3] + b0[3]);
              o.z = pk_bf16((z[4] - rs.x) * rs.y * g1[0] + b1[0], (z[5] - rs.x) * rs.y * g1[1] + b1[1]); o.w = pk_bf16((z[6] - rs.x) * rs.y * g1[2] + b1[2], (z[7] - rs.x) * rs.y * g1[3] + b1[3]);
              *(LAS u32x4*)(lds + VL_O + (ch32 >> 4) * 32768 + off_b(row, ch32 & 15)) = o; } }
        __syncthreads();
        if (u + ustep < uend) GM_ZLOAD(u + ustep);
        u32x2 uvr[4][4]; float bsr[4];
#pragma unroll
        for (int tt = 0; tt < 4; ++tt) { const int t = 32 * tt + r32; bsr[tt] = bsp[g * 128 + t]; const bf16* up = Z + (tok0 + t) * 4096 + g * 256 + 32 * wave + 4 * h2;
#pragma unroll
            for (int g4 = 0; g4 < 4; ++g4) uvr[tt][g4] = *(const u32x2*)(up + 8 * g4); }
        __builtin_amdgcn_sched_barrier(0);
        f32x16 acc[4];
#pragma unroll
        for (int tt = 0; tt < 4; ++tt)
#pragma unroll
            for (int i = 0; i < 16; ++i) acc[tt][i] = 0.f;
        LAS unsigned char* Vimg = lds + VL_O + (wave >> 2) * 32768; const int dt = wave & 3;
#pragma unroll
        for (int ks = 0; ks < 8; ++ks) {
            const unsigned rowb = 16 * ks + 8 * h2 + tq;
            const s16x4 alo = lds_tr(Vimg + off_b(rowb, 4 * dt + 2 * blk + (tp >> 1)) + 8 * (tp & 1)), ahi = lds_tr(Vimg + off_b(rowb + 4, 4 * dt + 2 * blk + (tp >> 1)) + 8 * (tp & 1));
            const bf16x8 va = __builtin_shufflevector(alo, ahi, 0, 1, 2, 3, 4, 5, 6, 7);
#pragma unroll
            for (int tt = ks >> 1; tt < 4; ++tt) { const bf16x8 wb = *(const LAS bf16x8*)(lds + W_O + off_b(32 * tt + r32, 2 * ks + h2)); acc[tt] = __builtin_amdgcn_mfma_f32_32x32x16_bf16(va, wb, acc[tt], 0, 0, 0); }
        }
#pragma unroll
        for (int tt = 0; tt < 4; ++tt) { const int t = 32 * tt + r32; const float bs = bsr[tt];
            unsigned char* yp = (unsigned char*)Y + (tok0 + t) * 2048 + g * 256 + 32 * wave + 4 * h2;
#pragma unroll
            for (int g4 = 0; g4 < 4; ++g4) { const u32x2 uv = uvr[tt][g4];
                int w8 = 0; w8 = __builtin_amdgcn_cvt_pk_fp8_f32(__uint_as_float(uv.x << 16) * (acc[tt][4 * g4] + bs), __uint_as_float(uv.x & 0xffff0000u) * (acc[tt][4 * g4 + 1] + bs), w8, false);
                w8 = __builtin_amdgcn_cvt_pk_fp8_f32(__uint_as_float(uv.y << 16) * (acc[tt][4 * g4 + 2] + bs), __uint_as_float(uv.y & 0xffff0000u) * (acc[tt][4 * g4 + 3] + bs), w8, true);
                *(int*)(yp + 8 * g4) = w8; } }
        __syncthreads();
    }
#undef GM_ZLOAD
}

template <int layer>
__device__ __forceinline__ void layer_body(const int lo, const int hi, const int G, const int bx, LAS unsigned char* lds, const XcdBarrier bar) {
        constexpr int mixer = layer % 3, j = layer / 3;
        const int vb = (G % 8 == 0) ? (bx % 8) * (G / 8) + bx / 8 : bx;
        int pid = 1 + (layer > 0 ? 7 : 0) + (layer > 1 ? 7 : 0) + (layer > 2 ? 9 : 0);
        if constexpr (mixer == 0) {
            PH_BEGIN
                pg8::Gemm g{HB, (const bf16*)(WSP + WS_AIN) + (size_t)j * 3072 * D, 2 * D}; pg8::StaticOrder S; S.init(T / 256, 12, G, bx);
                pg8::EpiBf16 E{BIG1, 3072, KMEAN};
                pg8::gemm_phase<pg8::EpiBf16, pg8::StaticOrder, true, false>(lds, g, S, E);
            PH_END
            PH_BEGIN
                attn_phase(lds, BIG1, BIG2, IN_(1), KMEAN, G, bx, tid);
            PH_END
            PH_BEGIN
                pg8::Gemm g{BIG2, (const bf16*)((unsigned char*)(WSP + WS_AOUT) + (size_t)j * D * D), D, 0x74747474}; pg8::StaticOrder S; S.init(T / 256, 4, G, bx);
                pg8::EpiResid E{HB, UB, ALPHA};
                pg8::gemm_phase<pg8::EpiResid, pg8::StaticOrder, true, false, true>(lds, g, S, E);
            PH_END
        } else if constexpr (mixer == 1) {
            PH_BEGIN
                pg8::Gemm g{(const bf16*)HB8, (const bf16*)(WSP + WS_BIN), D, FP8_GU_SCALE}; pg8::StaticOrder S; S.init(T / 256, 16, G, bx);
                pg8::EpiGelu E{BIG1, STATS};
                pg8::gemm_phase<pg8::EpiGelu, pg8::StaticOrder, true, false, true>(lds, g, S, E);
            PH_END
            PH_BEGIN
                gmlp_mix_phase(lds, BIG1, STATS, IN_(5), IN_(6), IN_(7), IN_(8), BIG2, G, bx, tid);
            PH_END
            PH_BEGIN
                pg8::Gemm g{BIG2, (const bf16*)(WSP + WS_BOUT), BW, 0x78787878}; pg8::StaticOrder S; S.init(T / 256, 4, G, bx);
                pg8::EpiResid E{HB, UB, ALPHA};
                pg8::gemm_phase<pg8::EpiResid, pg8::StaticOrder, true, false, true>(lds, g, S, E);
            PH_END
        } else {
            PH_BEGIN
                pg8::Gemm g{(const bf16*)HB8, (const bf16*)(WSP + WS_CIN), D, FP8_GU_SCALE}; pg8::StaticOrder S; S.init(T / 256, 12, G, bx);
                pg8::EpiBf16 E{BIG1, 3072};
                pg8::gemm_phase<pg8::EpiBf16, pg8::StaticOrder, true, false, true>(lds, g, S, E);
            PH_END
            PH_BEGIN
                gla_chunk_phase(lds, BIG1, GKL, IN_(11), IN_(12), GQE, OB, (bf16*)ACT, GDEC, G, bx, tid);
            PH_END
            PH_BEGIN
                gla_scan_phase(lds, GQE, OB, (const bf16*)ACT, GDEC, G, bx, tid);
            PH_END
            PH_BEGIN
                const float* ng = IN_(13);
                for (int ri = 0; ri < 8; ++ri) { const int row = (vb * NWAVES + wave) * 8 + ri;
#pragma unroll
                    for (int hd = 0; hd < 4; ++hd) { const u32x2 ov = *(const u32x2*)((const bf16*)OB + (size_t)row * 1024 + hd * 256 + 4 * lane);
                        const f32x4 o = {__uint_as_float(ov.x << 16), __uint_as_float(ov.x & 0xffff0000u), __uint_as_float(ov.y << 16), __uint_as_float(ov.y & 0xffff0000u)};
                        const float ss = wave_sum(o[0] * o[0] + o[1] * o[1] + o[2] * o[2] + o[3] * o[3]); const float r = 1.0f / sqrtf(ss * (1.0f / 256.0f) + LN_EPS);
                        const u32x2 gv = *(const u32x2*)(BIG1 + (size_t)row * 3072 + 2048 + hd * 256 + 4 * lane); const f32x4 gn = *(const f32x4*)(ng + 4 * lane);
                        const float gg[4] = {__uint_as_float(gv.x << 16), __uint_as_float(gv.x & 0xffff0000u), __uint_as_float(gv.y << 16), __uint_as_float(gv.y & 0xffff0000u)}; float y[4];
#pragma unroll
                        for (int i = 0; i < 4; ++i) y[i] = o[i] * (4.0f * r) * gn[i] * (gg[i] / (1.0f + __expf(-gg[i])));
                        int w8 = 0; w8 = __builtin_amdgcn_cvt_pk_fp8_f32(y[0], y[1], w8, false); w8 = __builtin_amdgcn_cvt_pk_fp8_f32(y[2], y[3], w8, true); *(int*)((unsigned char*)BIG2 + (size_t)row * 1024 + hd * 256 + 4 * lane) = w8; }
                }
            PH_END
            PH_BEGIN
                pg8::Gemm g{BIG2, (const bf16*)(WSP + WS_COUT), D, 0x76767676}; pg8::StaticOrder S; S.init(T / 256, 4, G, bx);
                pg8::EpiResid E{HB, UB, ALPHA};
                pg8::gemm_phase<pg8::EpiResid, pg8::StaticOrder, true, false, true>(lds, g, S, E);
            PH_END
        }

        LAS int* lcnt = (LAS int*)(lds + MISC_OFF + 256);
        LAS int* tstart = (LAS int*)(lds + MISC_OFF + 512);
        LAS int* tile_e = (LAS int*)(lds + MISC_OFF + 1024);
        LAS int* idxtab = (LAS int*)(lds + IDX_OFF);
        PH_BEGIN
            const float* lg = IN_(15) + (size_t)(layer * 2 + 0) * D; const float* lb = IN_(16) + (size_t)(layer * 2 + 0) * D;
            const bf16* wrh = WRH + (size_t)layer * NE * D; const bf16* wrl = WRL + (size_t)layer * NE * D; const float* brt = IN_(18) + layer * NE;
            LAS int* gbase = (LAS int*)(lds + IDX_OFF);
            LAS float* lgt = (LAS float*)(lds + IDX_OFF + 256) + wave * 256;
            LAS float* top = (LAS float*)(lds + IDX_OFF + 8448) + wave * 8;
            LAS float* rec = (LAS float*)(lds + IDX_OFF + 8704);
            if (tid < 32) lcnt[tid] = 0;
            __syncthreads();
            f32x4 y[8][4];
            {   f32x4 gv[4], bv[4];
#pragma unroll
                for (int jj = 0; jj < 4; ++jj) { gv[jj] = *(const f32x4*)(lg + 4 * lane + 256 * jj); bv[jj] = *(const f32x4*)(lb + 4 * lane + 256 * jj); }
                u32x2 raw[8][4];
#pragma unroll
                for (int i = 0; i < 8; ++i)
#pragma unroll
                    for (int jj = 0; jj < 4; ++jj) raw[i][jj] = *(const u32x2*)(UB + (size_t)(vb * 64 + wave * 8 + i) * D + 4 * lane + 256 * jj);
#pragma unroll
                for (int i = 0; i < 8; ++i) { const int row = vb * 64 + wave * 8 + i; float s = 0.f;
#pragma unroll
                    for (int jj = 0; jj < 4; ++jj) { const u32x2 uv = raw[i][jj];
                        y[i][jj] = (f32x4){__uint_as_float(uv.x << 16), __uint_as_float(uv.x & 0xffff0000u), __uint_as_float(uv.y << 16), __uint_as_float(uv.y & 0xffff0000u)};
                        s += (y[i][jj][0] + y[i][jj][1]) + (y[i][jj][2] + y[i][jj][3]); }
                    const float mean = wave_sum(s) * (1.0f / D); float s2 = 0.f;
#pragma unroll
                    for (int jj = 0; jj < 4; ++jj) { y[i][jj] = y[i][jj] - mean; s2 += (y[i][jj][0] * y[i][jj][0] + y[i][jj][1] * y[i][jj][1]) + (y[i][jj][2] * y[i][jj][2] + y[i][jj][3] * y[i][jj][3]); }
                    const float rstd = 1.0f / sqrtf(wave_sum(s2) * (1.0f / D) + LN_EPS);
#pragma unroll
                    for (int jj = 0; jj < 4; ++jj) { y[i][jj] = y[i][jj] * rstd * gv[jj] + bv[jj];
                        u32x2 w; w.x = cvt_pk_bf16(y[i][jj][0], y[i][jj][1]); w.y = cvt_pk_bf16(y[i][jj][2], y[i][jj][3]); *(u32x2*)(HB + (size_t)row * D + 4 * lane + 256 * jj) = w;
                        int w8 = 0; w8 = __builtin_amdgcn_cvt_pk_fp8_f32(y[i][jj][0], y[i][jj][1], w8, false); w8 = __builtin_amdgcn_cvt_pk_fp8_f32(y[i][jj][2], y[i][jj][3], w8, true); *(int*)(HB8 + (size_t)row * D + 4 * lane + 256 * jj) = w8; } }
            }
            {
                const int rt = wave & 1, kq = wave >> 1, r32 = lane & 31, h2 = lane >> 5;
                f32x16 lacc;
#pragma unroll
                for (int a = 0; a < 16; ++a) lacc[a] = 0.f;
#pragma unroll
                for (int jj = 0; jj < 4; ++jj) {
                    bf16x8 bh[4], bl[4];
#pragma unroll
                    for (int k4 = 0; k4 < 4; ++k4) { const size_t wo = (size_t)r32 * D + 256 * jj + 16 * (4 * kq + k4) + 8 * h2; bh[k4] = *(const bf16x8*)(wrh + wo); bl[k4] = *(const bf16x8*)(wrl + wo); }
#pragma unroll
                    for (int i = 0; i < 8; ++i) { const int row = wave * 8 + i; const f32x4 yv = y[i][jj];
                        const unsigned h0 = cvt_pk_bf16(yv[0], yv[1]), h1 = cvt_pk_bf16(yv[2], yv[3]);
                        const unsigned l0 = cvt_pk_bf16(yv[0] - __uint_as_float(h0 << 16), yv[1] - __uint_as_float(h0 & 0xffff0000u)), l1 = cvt_pk_bf16(yv[2] - __uint_as_float(h1 << 16), yv[3] - __uint_as_float(h1 & 0xffff0000u));
                        const unsigned ad = (lane >> 5) * 16384 + off_b(row, (lane & 31) >> 1) + 8 * (lane & 1);
                        *(LAS u32x2*)(lds + ad) = (u32x2){h0, h1}; *(LAS u32x2*)(lds + 32768 + ad) = (u32x2){l0, l1}; }
                    LDS_WAIT(); __builtin_amdgcn_s_barrier(); asm volatile("" ::: "memory");
#pragma unroll
                    for (int k4 = 0; k4 < 4; ++k4) { const int ks = 4 * kq + k4; const unsigned ad = (ks >> 3) * 16384 + off_b(32 * rt + r32, 2 * (ks & 7) + h2);
                        const bf16x8 ah = *(const LAS bf16x8*)(lds + ad), al = *(const LAS bf16x8*)(lds + 32768 + ad);
                        lacc = __builtin_amdgcn_mfma_f32_32x32x16_bf16(ah, bh[k4], lacc, 0, 0, 0);
                        lacc = __builtin_amdgcn_mfma_f32_32x32x16_bf16(ah, bl[k4], lacc, 0, 0, 0);
                        lacc = __builtin_amdgcn_mfma_f32_32x32x16_bf16(al, bh[k4], lacc, 0, 0, 0); }
                    LDS_WAIT(); __builtin_amdgcn_s_barrier(); asm volatile("" ::: "memory");
                }
                LAS float* red = (LAS float*)(lds + 65536);
#pragma unroll
                for (int a = 0; a < 16; ++a) red[(kq * 64 + 32 * rt + (a & 3) + 8 * (a >> 2) + 4 * h2) * 32 + r32] = lacc[a];
                LDS_WAIT(); __builtin_amdgcn_s_barrier(); asm volatile("" ::: "memory");
                if (lane < 32) {
#pragma unroll
                    for (int i = 0; i < 8; ++i) { const int row = wave * 8 + i; lgt[i * 32 + lane] = (red[(0 * 64 + row) * 32 + lane] + red[(1 * 64 + row) * 32 + lane]) + (red[(2 * 64 + row) * 32 + lane] + red[(3 * 64 + row) * 32 + lane]) + brt[lane]; }
                }
            }
            LDS_WAIT();
            {
                const int l31 = lane & 31, hh = lane >> 5; LAS float* tp2 = (LAS float*)(lds + IDX_OFF + 11776) + wave * 16 + hh * 8;
                for (int i = 0; i < 4; ++i) {
                    const int ri = i + 4 * hh, rl = wave * 8 + ri;
                    const float mylog = lgt[ri * 32 + l31];
                    int rank = 0;
                    for (int e = 0; e < NE; ++e) { const float o = lgt[ri * 32 + e]; rank += (o > mylog || (o == mylog && e < l31)) ? 1 : 0; }
                    if (rank < 4) { tp2[rank * 2] = mylog; tp2[rank * 2 + 1] = __int_as_float(l31); }
                    LDS_WAIT();
                    if (l31 < 4) { const float m0 = tp2[0]; const float e0 = __expf(tp2[0] - m0), e1 = __expf(tp2[2] - m0), e2 = __expf(tp2[4] - m0), e3 = __expf(tp2[6] - m0);
                        const float mine = __expf(tp2[l31 * 2] - m0) / ((e0 + e1) + (e2 + e3)); const int ex = __float_as_int(tp2[l31 * 2 + 1]);
                        const int lp = atomicAdd((int*)(lcnt + ex), 1);
                        rec[(rl * 4 + l31) * 3 + 0] = __int_as_float(ex); rec[(rl * 4 + l31) * 3 + 1] = __int_as_float(lp); rec[(rl * 4 + l31) * 3 + 2] = mine; }
                    LDS_WAIT();
                }
            }
            __syncthreads();
            if (tid < 32) gbase[tid] = (int)__hip_atomic_fetch_add((unsigned*)(cursor + tid), (unsigned)lcnt[tid], __ATOMIC_RELAXED, __HIP_MEMORY_SCOPE_AGENT);
            __syncthreads();
            if (tid < 256) { const int rl = tid >> 2, k = tid & 3, row = vb * 64 + rl;
                const int ex = __float_as_int(rec[tid * 3 + 0]), lp = __float_as_int(rec[tid * 3 + 1]); const float gt = rec[tid * 3 + 2];
                const int pos = gbase[ex] + lp;
                TOK[(size_t)ex * T + pos] = row; SELE[row * 4 + k] = ex; SELP[row * 4 + k] = pos; SELG[row * 4 + k] = gt; }
            if (hi - lo > 1) wq_drain(ap, layer, lane);
            else { for (int it_ = bx * NWAVES + wave; it_ < CONV_TOTAL; it_ += G * NWAVES) conv_unified(MOE_GU(layer), MOE_DN(layer), MOE_GUT(layer), MOE_DNT(layer), it_, it_ + 1, lane); }
            __syncthreads();
        PH_END
#define BUILD_TILES() do { if (tid < NE) lcnt[tid] = (int)__hip_atomic_load((unsigned*)(cursor + tid), __ATOMIC_RELAXED, __HIP_MEMORY_SCOPE_AGENT); __syncthreads(); \
            if (tid == 0) { int acc_ = 0; for (int e = 0; e < NE; ++e) { tstart[e] = acc_; acc_ += (lcnt[e] + 255) >> 8; } tstart[NE] = acc_; } __syncthreads(); \
            if (tid < NE) { const int t0_ = tstart[tid], t1_ = tstart[tid + 1]; for (int t_ = t0_; t_ < t1_; ++t_) tile_e[t_] = tid; } __syncthreads(); } while (0)
        PH_BEGIN
            BUILD_TILES();
            const int ntiles = tstart[NE];
            pg8::MoeOrder S; S.so.init(ntiles, 8, G, bx); S.tile_e = tile_e; S.idx = idxtab;
            { pg8::Unit u; for (int i = 0; i < MAXU && S.next(i, u); ++i) { if (tid < 256) { const int rr = (u.pm - tstart[u.e]) * 256 + tid; idxtab[i * 256 + tid] = (rr < lcnt[u.e]) ? TOK[(size_t)u.e * T + rr] : 0; } } }
            __syncthreads();
            pg8::Gemm g{(const bf16*)HB8, (const bf16*)((unsigned char*)(WSP + WS_GU) + (size_t)layer * NE * 2048 * D), D, FP8_GU_SCALE};
            pg8::EpiSwiglu E{(unsigned char*)ACT, IN_(20) + (size_t)layer * NE * 2048};
            pg8::gemm_phase<pg8::EpiSwiglu, pg8::MoeOrder, true, true, true>(lds, g, S, E);
        PH_END
#define M4_STAGE() do { const float* lg_ = IN_(15) + (size_t)(layer * 2 + 1) * D; const float* lb_ = IN_(16) + (size_t)(layer * 2 + 1) * D; const float* bdn_ = IN_(22) + (size_t)layer * NE * D; \
            LAS float* lgs_ = (LAS float*)(lds + IDX_OFF); LAS float* lbs_ = lgs_ + D; \
            if (tid < 256) { ((LAS f32x4*)lgs_)[tid] = ((const f32x4*)lg_)[tid]; ((LAS f32x4*)lbs_)[tid] = ((const f32x4*)lb_)[tid]; } \
            _Pragma("unroll 4") for (int i = tid; i < NE * D / 4; i += NTHR) { const f32x4 bv_ = ((const f32x4*)bdn_)[i]; u32x2 w_; w_.x = cvt_pk_bf16(bv_[0], bv_[1]); w_.y = cvt_pk_bf16(bv_[2], bv_[3]); ((LAS u32x2*)(lds + 65536))[i] = w_; } \
            if constexpr ((layer + 1) % 3 == 2) { for (int i = tid; i < 16 * D / 4; i += NTHR) ((LAS f32x4*)lds)[i] = ((const f32x4*)W16T)[i]; } } while (0)
        PH_BEGIN
            if (lo == pid) BUILD_TILES();
            const int ntiles = tstart[NE];
            pg8::MoeOrder S; S.so.init(ntiles, 4, G, bx); S.tile_e = tile_e; S.idx = idxtab;
            pg8::Gemm g{ACT, (const bf16*)((unsigned char*)(WSP + WS_DN) + (size_t)layer * NE * D * D), D, FP8_DN_SCALE};
            pg8::EpiYs8 E{(unsigned char*)YS};
            pg8::gemm_phase<pg8::EpiYs8, pg8::MoeOrder, true, false, true>(lds, g, S, E);
            if (hi - lo > 1) { __syncthreads(); M4_STAGE(); }
        PH_END
        PH_BEGIN
            if (lo == pid) BUILD_TILES();
            LAS float* lgs = (LAS float*)(lds + IDX_OFF); LAS float* lbs = lgs + D;
            if (lo == pid) M4_STAGE();
            __syncthreads();
#pragma unroll 1
            for (int rp = 0; rp < 4; ++rp) {
                const int rowa = (vb * NWAVES + wave) * 8 + 2 * rp;
                int lz = lane; asm volatile("" : "+v"(lz));
                f32x4 v[2][4];
                int ex[2][4], pos[2][4]; float gt[2][4];
#pragma unroll
                for (int q = 0; q < 2; ++q)
#pragma unroll
                    for (int k = 0; k < 4; ++k) { ex[q][k] = __builtin_amdgcn_readfirstlane(SELE[(rowa + q) * 4 + k]); pos[q][k] = __builtin_amdgcn_readfirstlane(SELP[(rowa + q) * 4 + k]);
                        gt[q][k] = __int_as_float(__builtin_amdgcn_readfirstlane(__float_as_int(SELG[(rowa + q) * 4 + k]))); }
#pragma unroll
                for (int q = 0; q < 2; ++q)
#pragma unroll
                    for (int jj = 0; jj < 4; ++jj) { const u32x2 hv = *(const u32x2*)(HB + (size_t)(rowa + q) * D + 4 * lz + 256 * jj);
                        v[q][jj] = (f32x4){__uint_as_float(hv.x << 16), __uint_as_float(hv.x & 0xffff0000u), __uint_as_float(hv.y << 16), __uint_as_float(hv.y & 0xffff0000u)} * ALPHA; }
                unsigned yv[2][4][4];
#pragma unroll
                for (int q = 0; q < 2; ++q)
#pragma unroll
                    for (int k = 0; k < 4; ++k) { const size_t gr = (size_t)tstart[ex[q][k]] * 256 + pos[q][k];
#pragma unroll
                        for (int jj = 0; jj < 4; ++jj) yv[q][k][jj] = *(const unsigned*)((const unsigned char*)YS + gr * 1024 + 4 * lz + 256 * jj); }
                __builtin_amdgcn_sched_barrier(0);
#pragma unroll
                for (int q = 0; q < 2; ++q)
#pragma unroll
                    for (int k = 0; k < 4; ++k) { const float g8 = gt[q][k] * 0.125f;
#pragma unroll
                        for (int jj = 0; jj < 4; ++jj) { const u32x2 bw_ = *(const LAS u32x2*)(lds + 65536 + ex[q][k] * 2048 + 8 * lz + 512 * jj);
                            const f32x4 bd = {__uint_as_float(bw_.x << 16), __uint_as_float(bw_.x & 0xffff0000u), __uint_as_float(bw_.y << 16), __uint_as_float(bw_.y & 0xffff0000u)};
                            const f32x2 lo = __builtin_amdgcn_cvt_pk_f32_fp8((int)yv[q][k][jj], false), hi = __builtin_amdgcn_cvt_pk_f32_fp8((int)yv[q][k][jj], true);
                            v[q][jj][0] += g8 * lo.x + gt[q][k] * bd[0]; v[q][jj][1] += g8 * lo.y + gt[q][k] * bd[1]; v[q][jj][2] += g8 * hi.x + gt[q][k] * bd[2]; v[q][jj][3] += g8 * hi.y + gt[q][k] * bd[3]; }
                        __builtin_amdgcn_sched_barrier(0); }
#pragma unroll
                for (int q = 0; q < 2; ++q) { const int row = rowa + q;
                    float s = 0.f;
#pragma unroll
                    for (int jj = 0; jj < 4; ++jj) s += (v[q][jj][0] + v[q][jj][1]) + (v[q][jj][2] + v[q][jj][3]);
                    const float mean = wave_sum(s) * (1.0f / D); float s2 = 0.f;
#pragma unroll
                    for (int jj = 0; jj < 4; ++jj) { v[q][jj] = v[q][jj] - mean; s2 += (v[q][jj][0] * v[q][jj][0] + v[q][jj][1] * v[q][jj][1]) + (v[q][jj][2] * v[q][jj][2] + v[q][jj][3] * v[q][jj][3]); }
                    const float rstd = 1.0f / sqrtf(wave_sum(s2) * (1.0f / D) + LN_EPS);
#pragma unroll
                    for (int jj = 0; jj < 4; ++jj) { const f32x4 gq = *(const LAS f32x4*)(lgs + 4 * lz + 256 * jj), bq = *(const LAS f32x4*)(lbs + 4 * lz + 256 * jj);
                        v[q][jj] = v[q][jj] * rstd * gq + bq;
                        if constexpr (layer == NLAYER - 1) *(f32x4*)(Hf + (size_t)row * D + 4 * lz + 256 * jj) = v[q][jj];
                        if constexpr (layer < NLAYER - 1) { u32x2 w; w.x = cvt_pk_bf16(v[q][jj][0], v[q][jj][1]); w.y = cvt_pk_bf16(v[q][jj][2], v[q][jj][3]); *(u32x2*)(HB + (size_t)row * D + 4 * lz + 256 * jj) = w; }
                        if constexpr ((layer + 1) % 3 != 0 && layer + 1 < NLAYER) { int w8 = 0; w8 = __builtin_amdgcn_cvt_pk_fp8_f32(v[q][jj][0], v[q][jj][1], w8, false); w8 = __builtin_amdgcn_cvt_pk_fp8_f32(v[q][jj][2], v[q][jj][3], w8, true); *(int*)(HB8 + (size_t)row * D + 4 * lz + 256 * jj) = w8; } }
                    if constexpr ((layer + 1) % 3 == 2) {
                        float r[16];
#pragma unroll
                        for (int i = 0; i < 16; ++i) { r[i] = 0.f;
#pragma unroll
                            for (int jj = 0; jj < 4; ++jj) { const f32x4 w4 = *(const LAS f32x4*)((LAS float*)lds + i * D + 4 * lz + 256 * jj); r[i] += (v[q][jj][0] * w4[0] + v[q][jj][1] * w4[1]) + (v[q][jj][2] * w4[2] + v[q][jj][3] * w4[3]); } }
#pragma unroll
                        for (int q8 = 0; q8 < 8; ++q8) { const bool hi_ = (lz & 32) != 0; const float keep = hi_ ? r[q8 + 8] : r[q8], send = hi_ ? r[q8] : r[q8 + 8]; r[q8] = keep + __shfl_xor(send, 32); }
#pragma unroll
                        for (int q8 = 0; q8 < 4; ++q8) { const bool hi_ = (lz & 16) != 0; const float keep = hi_ ? r[q8 + 4] : r[q8], send = hi_ ? r[q8] : r[q8 + 4]; r[q8] = keep + __shfl_xor(send, 16); }
#pragma unroll
                        for (int q8 = 0; q8 < 2; ++q8) { const bool hi_ = (lz & 8) != 0; const float keep = hi_ ? r[q8 + 2] : r[q8], send = hi_ ? r[q8] : r[q8 + 2]; r[q8] = keep + __shfl_xor(send, 8); }
                        { const bool hi_ = (lz & 4) != 0; const float keep = hi_ ? r[1] : r[0], send = hi_ ? r[0] : r[1]; r[0] = keep + __shfl_xor(send, 4); }
                        r[0] += __shfl_xor(r[0], 2); r[0] += __shfl_xor(r[0], 1);
                        if ((lz & 3) == 0) GKL[(size_t)row * 16 + (lz >> 2)] = r[0];
                    }
                }
            }
            __syncthreads();
        PH_END
}

__global__ void __launch_bounds__(NTHR, 2) fwd_kernel(Args args) {
    extern __shared__ __attribute__((aligned(16))) unsigned char lds_raw[];
    LAS unsigned char* lds = (LAS unsigned char*)lds_raw;
    const int G = gridDim.x, bx = blockIdx.x;
    volatile LAS unsigned* MISC = (volatile LAS unsigned*)(lds + MISC_OFF);
    if (threadIdx.x < 64) MISC[threadIdx.x] = 0u;
    __syncthreads();
    const int lo = args.ph_lo, hi = args.ph_hi;
    XcdBarrier bar; bar.bar = (unsigned*)((gu32*)(args.ws + WS_CTL) + CW_BAR); bar.x = 0; bar.st = MISC;
    if (hi - lo > 1) { bar = xcd_barrier_post(bar.bar, MISC);
        if (threadIdx.x == 0 && ((xb_xcc_id() & 7u) != (unsigned)(bx & 7) || G != 256)) (void)xb_add(&bar.bar[XB_MIS], 1u); }
    int pid = 0;
    PH_BEGIN
        conv_mats(IN_(2), 2, D, 3072, 3072, (bf16*)(WSP + WS_AIN), false, gw, NGW, lane);
        for (int it = gw; it < 3072; it += NGW) {
            if (it < 1024) conv_fp8(IN_(4), (unsigned char*)(WSP + WS_BIN), 4096, it, false, (float)(1 << FP8_GU_SHIFT), lane);
            else if (it < 1792) conv_fp8(IN_(10), (unsigned char*)(WSP + WS_CIN), 3072, it - 1024, false, (float)(1 << FP8_GU_SHIFT), lane, CIN);
            else if (it < 2304) conv_fp8(IN_(9), (unsigned char*)(WSP + WS_BOUT), D, it - 1792, false, (float)(1 << FP8_DN_SHIFT), lane, 0, BW);
            else if (it < 2816) conv_fp8(IN_(3), (unsigned char*)(WSP + WS_AOUT), D, it - 2304, false, (float)(1 << FP8_DN_SHIFT), lane);
            else conv_fp8(IN_(14), (unsigned char*)(WSP + WS_COUT), D, it - 2816, false, (float)(1 << FP8_DN_SHIFT), lane); }
        for (int i = bx * NTHR + tid; i < NLAYER * NE * D; i += G * NTHR) { const int l = i / (NE * D), r = i % (NE * D), e = r / D, d = r % D; const float w = IN_(17)[(size_t)l * D * NE + (size_t)d * NE + e];
            const bf16 hi = f2bf(w); WRH[i] = hi; WRL[i] = f2bf(w - bf2f(hi)); }
        for (int i = bx * NTHR + tid; i < 16 * D; i += G * NTHR) { const int c = i / D, d = i % D; W16T[i] = IN_(10)[(size_t)d * CIN + 3072 + c]; }
        for (size_t i = (size_t)(bx * NTHR + tid); i < (size_t)T * D / 4; i += (size_t)G * NTHR) { const f32x4 v = ((const f32x4*)IN_(0))[i]; u32x2 w; w.x = cvt_pk_bf16(v[0], v[1]); w.y = cvt_pk_bf16(v[2], v[3]); ((u32x2*)HB)[i] = w; }
    PH_END

    layer_body<0>(lo, hi, G, bx, lds, bar);
    layer_body<1>(lo, hi, G, bx, lds, bar);
    layer_body<2>(lo, hi, G, bx, lds, bar);
    layer_body<3>(lo, hi, G, bx, lds, bar);
}

static int count_phases() { int n = 1; for (int l = 0; l < NLAYER; ++l) { const int m = l % 3; n += (m == 0 ? 3 : (m == 1 ? 3 : 5)) + 4; } return n; }

extern "C" void kernel_launch(void* const* d_in, const int* in_sizes, int n_in, void* d_out, int out_size, void* d_ws, size_t ws_size, hipStream_t stream) {
    static int grid = 0;
    if (grid == 0) {
        if (n_in != 23 || out_size != T * D || ws_size < WS_END) { fprintf(stderr, "kernel_launch: unexpected problem (n_in %d out %d ws %zu)\n", n_in, out_size, ws_size); grid = -1; return; }
        int dev = 0, cus = 0;
        hipGetDevice(&dev); hipDeviceGetAttribute(&cus, hipDeviceAttributeMultiprocessorCount, dev);
        if (hipFuncSetAttribute((const void*)fwd_kernel, hipFuncAttributeMaxDynamicSharedMemorySize, LDS_BYTES) != hipSuccess) { fprintf(stderr, "kernel_launch: hipFuncSetAttribute failed\n"); grid = -1; return; }
        int per_cu = 0;
        if (hipOccupancyMaxActiveBlocksPerMultiprocessor(&per_cu, (const void*)fwd_kernel, NTHR, LDS_BYTES) != hipSuccess || per_cu < 1) fprintf(stderr, "kernel_launch: occupancy query says %d\n", per_cu);
        (void)hipGetLastError();
        grid = 256; (void)cus;
    }
    if (grid < 0) return;
    hipMemsetAsync((char*)d_ws + WS_CTL, 0, CTL_ZERO_BYTES, stream);
    Args a{};
    for (int i = 0; i < 23; ++i) a.in[i] = (const float*)d_in[i];
    a.out = (float*)d_out; a.ws = (unsigned char*)d_ws;
    const int NP = count_phases();
#if MK_ONE_LAUNCH
    a.ph_lo = 0; a.ph_hi = NP;
    hipLaunchKernelGGL(fwd_kernel, dim3(grid), dim3(NTHR), LDS_BYTES, stream, a);
#else
    for (int p = 0; p < NP; ++p) { a.ph_lo = p; a.ph_hi = p + 1; hipLaunchKernelGGL(fwd_kernel, dim3(grid), dim3(NTHR), LDS_BYTES, stream, a); }
#endif
}
```
